# Optimizing an MI355X kernel written in HIP

```python
import jax, jax.numpy as jnp
from jax import lax
import numpy as np

D_MODEL = 1024
BATCH = 8
SEQ = 8192
DEPTH = 2

HEAD_DIM = 64
N_HEADS_A = 8
N_HEADS_B = 8
N_KV_B = 2
GQA_GROUP = N_HEADS_B // N_KV_B
MIX_A = N_HEADS_A * HEAD_DIM
MIX_B = N_HEADS_B * HEAD_DIM
KV_B = N_KV_B * HEAD_DIM
PROJ_WIDTH = 3 * MIX_A + MIX_B + 2 * KV_B
SPLITS = (MIX_A, 2 * MIX_A, 3 * MIX_A, 3 * MIX_A + MIX_B, 3 * MIX_A + MIX_B + KV_B)
DILATED_CONFIGS = ((128, 1), (512, 4), (2048, 16))
SWA_WINDOW = 128
BLOCK = 128
ROPE_THETA = 500000.0
ROPE_DIM = HEAD_DIM // 4
N_GROUPS = 4
EXPERTS_PER_GROUP = 8
N_EXPERTS = N_GROUPS * EXPERTS_PER_GROUP
TOP_K = 2
D_EXPERT = 512
EPS = 1e-6

kernel_name = 'hybrid_dilated_swa_sink_hmoe'


def rmsnorm(x, g):
    xf = x.astype(jnp.float32)
    y = xf * lax.rsqrt(jnp.mean(xf * xf, axis=-1, keepdims=True) + EPS)
    return (y * g.astype(jnp.float32)).astype(x.dtype)


def rope_tables(positions):
    inv_freq = ROPE_THETA ** (-jnp.arange(0, ROPE_DIM, 2, dtype=jnp.float32) / ROPE_DIM)
    ang = positions.astype(jnp.float32)[..., None] * inv_freq
    return jnp.cos(ang)[:, :, None, :], jnp.sin(ang)[:, :, None, :]


def apply_partial_rope(x, cos, sin):
    half = ROPE_DIM // 2
    x1 = x[..., :half].astype(jnp.float32)
    x2 = x[..., half:ROPE_DIM].astype(jnp.float32)
    rot = jnp.concatenate([x1 * cos - x2 * sin, x2 * cos + x1 * sin], axis=-1).astype(x.dtype)
    return jnp.concatenate([rot, x[..., ROPE_DIM:]], axis=-1)


def banded_attention(q, k, v, max_back, sink=None):
    n, hd = q.shape[-2], q.shape[-1]
    nb = -(-n // BLOCK)
    pad = nb * BLOCK - n
    if pad:
        q = jnp.pad(q, [(0, 0)] * (q.ndim - 2) + [(0, pad), (0, 0)])
        k = jnp.pad(k, [(0, 0)] * (k.ndim - 2) + [(0, pad), (0, 0)])
        v = jnp.pad(v, [(0, 0)] * (v.ndim - 2) + [(0, pad), (0, 0)])
    qb = q.reshape(q.shape[:-2] + (nb, BLOCK, hd))

    def with_prev(t):
        tb = t.reshape(t.shape[:-2] + (nb, BLOCK, hd))
        prev = jnp.concatenate([jnp.zeros_like(tb[..., :1, :, :]), tb[..., :-1, :, :]], axis=-3)
        return jnp.concatenate([prev, tb], axis=-2)

    kc, vc = with_prev(k), with_prev(v)
    s = jnp.einsum('...hgnqd,...hnkd->...hgnqk', qb, kc,
                   preferred_element_type=jnp.float32) * (hd ** -0.5)
    qi = jnp.arange(BLOCK)[:, None]
    kj = jnp.arange(2 * BLOCK)[None, :]
    dist = BLOCK + qi - kj
    kpos = (jnp.arange(nb)[:, None, None] - 1) * BLOCK + kj[None]
    valid = (dist >= 0) & (dist <= max_back) & (kpos >= 0)
    s = jnp.where(valid, s, -jnp.inf)
    m = jnp.max(s, axis=-1)
    if sink is not None:
        sk = sink.astype(jnp.float32)[:, :, None, None]
        m = jnp.maximum(m, sk)
    p = jnp.exp(s - m[..., None])
    denom = jnp.sum(p, axis=-1)
    if sink is not None:
        denom = denom + jnp.exp(sk - m)
    o = jnp.einsum('...hgnqk,...hnkd->...hgnqd', p, vc.astype(jnp.float32)) / denom[..., None]
    lse = m + jnp.log(denom)
    o = o.reshape(o.shape[:-3] + (nb * BLOCK, hd))[..., :n, :]
    lse = lse.reshape(lse.shape[:-2] + (nb * BLOCK,))[..., :n]
    return o.astype(q.dtype), lse


def dilated_attention(q, k, v):
    b, s, h, hd = q.shape
    outs, lses = [], []
    for window, dil in DILATED_CONFIGS:
        n = s // dil

        def split(t):
            return t.reshape(b, n, dil, h, hd).transpose(0, 2, 3, 1, 4)

        o, lse = banded_attention(split(q)[:, :, :, None], split(k), split(v), window // dil)
        outs.append(o[:, :, :, 0].transpose(0, 3, 1, 2, 4).reshape(b, s, h, hd))
        lses.append(lse[:, :, :, 0].transpose(0, 3, 1, 2).reshape(b, s, h))
    w = jax.nn.softmax(jnp.stack(lses, axis=0), axis=0)
    o = jnp.sum(w[..., None] * jnp.stack(outs, axis=0).astype(jnp.float32), axis=0)
    return o.astype(q.dtype)


def sink_swa_attention(q, k, v, sinks):
    b, s, _, hd = q.shape
    qg = q.reshape(b, s, N_KV_B, GQA_GROUP, hd).transpose(0, 2, 3, 1, 4)
    o, _ = banded_attention(qg, k.transpose(0, 2, 1, 3), v.transpose(0, 2, 1, 3),
                            SWA_WINDOW - 1, sink=sinks.reshape(N_KV_B, GQA_GROUP))
    return o.transpose(0, 3, 1, 2, 4).reshape(b, s, N_HEADS_B * hd)


def hierarchical_moe(h, w_rg, w_re, w_gu, w_dn):
    b, s, d = h.shape
    t = h.reshape(b * s, d)
    g_prob = jax.nn.softmax(jnp.einsum('td,dg->tg', t, w_rg).astype(jnp.float32), axis=-1)
    g_top, g_idx = lax.top_k(g_prob, 1)
    e_logits = jnp.einsum('td,de->te', t, w_re).astype(jnp.float32)
    e_logits = e_logits.reshape(-1, N_GROUPS, EXPERTS_PER_GROUP)
    e_logits = jnp.einsum('tge,tg->te', e_logits,
                          jax.nn.one_hot(g_idx[:, 0], N_GROUPS, dtype=jnp.float32))
    e_top, e_idx = lax.top_k(jax.nn.softmax(e_logits, axis=-1), TOP_K)
    gate = g_top * e_top / jnp.sum(e_top, axis=-1, keepdims=True)
    flat = (g_idx * EXPERTS_PER_GROUP + e_idx).reshape(-1)
    order = jnp.argsort(flat)
    xs = t[order // TOP_K]
    sizes = jnp.bincount(flat, length=N_EXPERTS).astype(jnp.int32)
    gu = lax.ragged_dot(xs, w_gu, sizes)
    a = jax.nn.silu(gu[:, :D_EXPERT]) * gu[:, D_EXPERT:]
    ys = lax.ragged_dot(a, w_dn, sizes)
    ys = ys[jnp.argsort(order)].reshape(-1, TOP_K, d)
    y = jnp.einsum('tkd,tk->td', ys.astype(jnp.float32), gate)
    return y.astype(h.dtype).reshape(b, s, d)


def setup_inputs(seed: int = 0) -> dict:
    key = jax.random.key(seed)
    ks = jax.random.split(key, 20)
    f32 = jnp.float32
    L, D = DEPTH, D_MODEL

    def gain(k, shape):
        return 1.0 + 0.02 * jax.random.normal(k, shape, f32)

    x = jax.random.normal(ks[0], (BATCH, SEQ, D), f32)
    offset = jax.random.randint(ks[1], (BATCH, 1), 0, 4096, dtype=jnp.int32)
    positions = (jnp.arange(SEQ, dtype=jnp.int32)[None, :] + offset).astype(jnp.int32)
    return {
        'x': x,
        'positions': positions,
        'attn_norm': gain(ks[2], (L, D)),
        'w_in': jax.random.normal(ks[3], (L, D, PROJ_WIDTH), f32) * D ** -0.5,
        'q_norm_a': gain(ks[4], (L, HEAD_DIM)),
        'k_norm_a': gain(ks[5], (L, HEAD_DIM)),
        'q_norm_b': gain(ks[6], (L, HEAD_DIM)),
        'k_norm_b': gain(ks[7], (L, HEAD_DIM)),
        'sinks_b': 0.5 * jax.random.normal(ks[8], (L, N_HEADS_B), f32),
        'out_norm_a': gain(ks[9], (L, MIX_A)),
        'out_norm_b': gain(ks[10], (L, MIX_B)),
        'w_out': jax.random.normal(ks[11], (L, MIX_A + MIX_B, D), f32) * (MIX_A + MIX_B) ** -0.5,
        'ffn_norm': gain(ks[12], (L, D)),
        'w_router_group': jax.random.normal(ks[13], (L, D, N_GROUPS), f32) * D ** -0.5,
        'w_router_expert': jax.random.normal(ks[14], (L, D, N_EXPERTS), f32) * D ** -0.5,
        'w_gate_up': jax.random.normal(ks[15], (L, N_EXPERTS, D, 2 * D_EXPERT), f32) * D ** -0.5,
        'w_down': jax.random.normal(ks[16], (L, N_EXPERTS, D_EXPERT, D), f32) * D_EXPERT ** -0.5,
    }


def reference(x, positions, attn_norm, w_in, q_norm_a, k_norm_a, q_norm_b, k_norm_b, sinks_b,
              out_norm_a, out_norm_b, w_out, ffn_norm, w_router_group, w_router_expert,
              w_gate_up, w_down):
    b, s, _ = x.shape
    cos, sin = rope_tables(positions)
    for l in range(DEPTH):
        h = rmsnorm(x, attn_norm[l])
        proj = jnp.einsum('bsd,dp->bsp', h, w_in[l])
        qa, ka, va, qb, kb, vb = jnp.split(proj, SPLITS, axis=-1)
        qa = qa.reshape(b, s, N_HEADS_A, HEAD_DIM)
        ka = ka.reshape(b, s, N_HEADS_A, HEAD_DIM)
        va = va.reshape(b, s, N_HEADS_A, HEAD_DIM)
        qb = qb.reshape(b, s, N_HEADS_B, HEAD_DIM)
        kb = kb.reshape(b, s, N_KV_B, HEAD_DIM)
        vb = vb.reshape(b, s, N_KV_B, HEAD_DIM)
        qa = apply_partial_rope(rmsnorm(qa, q_norm_a[l]), cos, sin)
        ka = apply_partial_rope(rmsnorm(ka, k_norm_a[l]), cos, sin)
        qb = apply_partial_rope(rmsnorm(qb, q_norm_b[l]), cos, sin)
        kb = apply_partial_rope(rmsnorm(kb, k_norm_b[l]), cos, sin)
        oa = dilated_attention(qa, ka, va).reshape(b, s, MIX_A)
        ob = sink_swa_attention(qb, kb, vb, sinks_b[l])
        mixed = jnp.concatenate([rmsnorm(oa, out_norm_a[l]), rmsnorm(ob, out_norm_b[l])], axis=-1)
        x = x + jnp.einsum('bsm,md->bsd', mixed, w_out[l])
        h = rmsnorm(x, ffn_norm[l])
        x = x + hierarchical_moe(h, w_router_group[l], w_router_expert[l], w_gate_up[l], w_down[l])
    return x
```

```cpp
#include <hip/hip_runtime.h>
#include <cstdio>
#include <cstdint>

#ifndef MK_N_LAUNCHES
#define MK_N_LAUNCHES 1
#endif

#define LAS __attribute__((address_space(3)))
#define GAS __attribute__((address_space(1)))
typedef unsigned short bf16_t;
typedef short bf16x8 __attribute__((ext_vector_type(8)));
typedef float f32x4 __attribute__((ext_vector_type(4)));
typedef float f32x16 __attribute__((ext_vector_type(16)));
typedef unsigned u32x4 __attribute__((ext_vector_type(4)));
typedef GAS unsigned gu32;

constexpr int BATCH = 8, SEQ = 8192, T = BATCH * SEQ, D = 1024, DEPTH = 2, HD = 64, PW = 2304;
constexpr int NE = 32, DE = 512, NBK = 112, CAP = 65536;
constexpr float EPS = 1e-6f, LOG2E = 1.4426950408889634f, QSCALE = 0.125f * 1.4426950408889634f;
constexpr int NWAVES = 8, NTHREADS = 512;
constexpr int PPL = 7;
constexpr int NPHASE = 1 + PPL * DEPTH;
constexpr float SW_GU = 128.f, SW_DN = 64.f, SA_A = 16.f;
constexpr int MAXU = 12;

constexpr size_t MiB = 1u << 20;
constexpr size_t WS_CTL = 0, CTL_ZERO_BYTES = 65536;
constexpr size_t WS_ROPE = 1 * MiB;
constexpr size_t WS_SSQ1 = 5 * MiB;
constexpr size_t WS_SSQ2 = 9 * MiB;
constexpr size_t WS_TOKINFO = 13 * MiB;
constexpr size_t WS_GAINS = 15 * MiB;
constexpr size_t WS_WR = 14 * MiB;
constexpr size_t WS_LIST = 16 * MiB;
constexpr size_t WS_WIN = 44 * MiB;
constexpr size_t WS_WOUT = 53 * MiB;
constexpr size_t WS_WGU8 = 57 * MiB;
constexpr size_t WS_WDN8 = 121 * MiB;
constexpr size_t WS_XF8 = 153 * MiB;
constexpr size_t WS_TOKROW = 225 * MiB;
constexpr size_t WS_ELIST = 217 * MiB;
constexpr size_t WS_QKV = 256 * MiB;
constexpr size_t WS_MIXED = 544 * MiB;
constexpr size_t WS_XB1 = 672 * MiB;
constexpr size_t WS_XN = 800 * MiB;
constexpr size_t WS_OBR = 672 * MiB;
constexpr size_t WS_LSE = 928 * MiB;
constexpr size_t WS_SSQA = 932 * MiB;
constexpr size_t WS_SSQB = 934 * MiB;
constexpr size_t WS_END = 936 * MiB;
constexpr int CW_ECNT = 320;
constexpr int CW_GCNT = 64;
constexpr int CW_BAR = 1024;

constexpr int RING_OFF = 0, RING_BYTES = 131072;
constexpr int TOK_OFF = 131072;
constexpr int UNIT_OFF = TOK_OFF + MAXU * 256 * 4;
constexpr int CNT_OFF = UNIT_OFF + 256;
constexpr int TST_OFF = CNT_OFF + 512;
constexpr int LBASE_OFF = TST_OFF + 512;
constexpr int MISC_OFF = LBASE_OFF + 512;
constexpr int EPST_OFF = 147456;
constexpr int LDS_BYTES = 163840;
static_assert(MISC_OFF + 128 <= EPST_OFF && EPST_OFF + 8 * 2048 <= LDS_BYTES, "LDS map");

extern __shared__ __attribute__((aligned(16))) unsigned char g_lds[];
#define LDSP(off) ((LAS unsigned char*)g_lds + (off))

__device__ __forceinline__ unsigned f2bf(float f) { unsigned u = __builtin_bit_cast(unsigned, f); return (u + 0x7fffu + ((u >> 16) & 1u)) >> 16; }
typedef float f32x2_t __attribute__((ext_vector_type(2))); typedef __bf16 bf16x2_t __attribute__((ext_vector_type(2)));
__device__ __forceinline__ unsigned pk2(float lo, float hi) { const f32x2_t v = {lo, hi}; const bf16x2_t b = __builtin_convertvector(v, bf16x2_t); return __builtin_bit_cast(unsigned, b); }
__device__ __forceinline__ float bflo(unsigned w) { return __builtin_bit_cast(float, w << 16); }
__device__ __forceinline__ float bfhi(unsigned w) { return __builtin_bit_cast(float, w & 0xffff0000u); }
__device__ __forceinline__ u32x4 pack8(const f32x4& a, const f32x4& b) { u32x4 w; w.x = pk2(a[0], a[1]); w.y = pk2(a[2], a[3]); w.z = pk2(b[0], b[1]); w.w = pk2(b[2], b[3]); return w; }
typedef int i32x4 __attribute__((ext_vector_type(4))); typedef int i32x8 __attribute__((ext_vector_type(8)));
__device__ __forceinline__ unsigned pk4_fp8(float a, float b, float c, float d) { int w = __builtin_amdgcn_cvt_pk_fp8_f32(a, b, 0, false); w = __builtin_amdgcn_cvt_pk_fp8_f32(c, d, w, true); return (unsigned)w; }
__device__ __forceinline__ float xor32_f(float x, bool upper  ) { float a = x, b = x; asm volatile("s_nop 1\n\tv_permlane32_swap_b32 %0, %1" : "+v"(a), "+v"(b)); return upper ? a : b; }
__device__ __forceinline__ float sum_xor32(float x) { float a = x, b = x; asm volatile("s_nop 1\n\tv_permlane32_swap_b32 %0, %1" : "+v"(a), "+v"(b)); return a + b; }
__device__ __forceinline__ float sum_xor16(float x) { float a = x, b = x; asm volatile("s_nop 1\n\tv_permlane16_swap_b32 %0, %1" : "+v"(a), "+v"(b)); return a + b; }
__device__ __forceinline__ float vmax3(float a, float b, float c) { float d; asm("v_max3_f32 %0, %1, %2, %3" : "=v"(d) : "v"(a), "v"(b), "v"(c)); return d; }
__device__ __forceinline__ float wave_sum(float v) {
#pragma unroll
    for (int o = 1; o < 64; o <<= 1) v += __shfl_xor(v, o);
    return v;
}
#define LDS_WAIT() asm volatile("s_waitcnt lgkmcnt(0)" ::: "memory")
#define LDS_BARRIER() do { asm volatile("s_waitcnt lgkmcnt(0)" ::: "memory"); __builtin_amdgcn_s_barrier(); asm volatile("" ::: "memory"); } while (0)
__device__ __forceinline__ int lane_id() { unsigned z = 0u; asm volatile("" : "+v"(z)); return (int)__builtin_amdgcn_mbcnt_hi(~0u, __builtin_amdgcn_mbcnt_lo(~0u, z)); }

#define XB_TMO      128
#define XB_XCNT(j)  (256  + 64 * (j))
#define XB_XSUB(j)  (1280 + 64 * (j))
#define XB_XGEN(j)  (2304 + 64 * (j))
#define XB_TOP      3328
#define XB_TOPGEN   3392
#define XCD_BAR_WORDS 3456
#define XB_SPIN_CAP (1u << 24)
__device__ __forceinline__ unsigned xb_ld(unsigned* p)              { return __hip_atomic_load(p, __ATOMIC_RELAXED, __HIP_MEMORY_SCOPE_AGENT); }
__device__ __forceinline__ unsigned xb_add(unsigned* p, unsigned v) { return __hip_atomic_fetch_add(p, v, __ATOMIC_RELAXED, __HIP_MEMORY_SCOPE_AGENT); }
__device__ __forceinline__ unsigned xb_xcc_id() { return (unsigned)__builtin_amdgcn_s_getreg((3 << 11) | 20) & 0xFu; }
#define XB_SPIN(cond, bar) do { unsigned _sp = 0; while (cond) { __builtin_amdgcn_s_sleep(1); \
    if ((++_sp & 255u) == 0u) { if (xb_ld(&(bar)[XB_TMO])) break; if (_sp > XB_SPIN_CAP) { atomicAdd(&(bar)[XB_TMO], 1u); break; } } } } while (0)
struct XcdBarrier { unsigned* bar; volatile LAS unsigned* st; };
__device__ __forceinline__ XcdBarrier xcd_barrier_post(unsigned* bar, volatile LAS unsigned* st) {
    XcdBarrier b; b.bar = bar; b.st = st;
    if (threadIdx.x == 0) (void)xb_add(&bar[XB_XCNT(xb_xcc_id())], 1u);
    return b;
}
__device__ __forceinline__ void xcd_barrier_complete(unsigned* bar, unsigned x, unsigned& nloc, unsigned& nx) {
    const unsigned G = gridDim.x * gridDim.y * gridDim.z;
    unsigned sum, cnt, mine, sp = 0u;
    for (;;) {
        sum = 0u; cnt = 0u; mine = 0u;
#pragma unroll
        for (unsigned j = 0; j < 16; ++j) { const unsigned c = xb_ld(&bar[XB_XCNT(j)]); sum += c; cnt += (c > 0u) ? 1u : 0u; mine = (j == x) ? c : mine; }
        if (sum == G) break;
        __builtin_amdgcn_s_sleep(1);
        if ((++sp & 255u) == 0u) { if (xb_ld(&bar[XB_TMO])) break; if (sp > XB_SPIN_CAP) { atomicAdd(&bar[XB_TMO], 1u); break; } }
    }
    nloc = mine > 0u ? mine : 1u; nx = cnt > 0u ? cnt : 1u;
}
__device__ __forceinline__ void xcd_barrier(const XcdBarrier& b, int wave) {
    asm volatile("s_waitcnt vmcnt(0)" ::: "memory");
    __syncthreads();
    if (wave == 0 && lane_id() == 0) {
        unsigned* bar = b.bar; const unsigned bx = xb_xcc_id();
        __builtin_amdgcn_s_waitcnt(0);
        unsigned nloc = b.st[0], nx = b.st[1];
        if (nloc == 0u) { xcd_barrier_complete(bar, bx, nloc, nx); b.st[0] = nloc; b.st[1] = nx; }
        const unsigned old = xb_add(&bar[XB_XSUB(bx)], 1u);
        const unsigned gen = old / nloc;
        if (old + 1u == (gen + 1u) * nloc) {
            __builtin_amdgcn_fence(__ATOMIC_RELEASE, "agent");
            asm volatile("s_waitcnt vmcnt(0)" ::: "memory");
            const unsigned og = xb_add(&bar[XB_TOP], 1u);
            const unsigned tg = og / nx;
            if (og + 1u == (tg + 1u) * nx) xb_add(&bar[XB_TOPGEN], 1u);
            else XB_SPIN(xb_ld(&bar[XB_TOPGEN]) == tg, bar);
            __builtin_amdgcn_fence(__ATOMIC_ACQUIRE, "agent");
            xb_add(&bar[XB_XGEN(bx)], 1u);
            asm volatile("s_waitcnt vmcnt(0)" ::: "memory");
        } else {
            XB_SPIN(xb_ld(&bar[XB_XGEN(bx)]) == gen, bar);
            __builtin_amdgcn_fence(__ATOMIC_ACQUIRE, "agent");
            asm volatile("s_waitcnt vmcnt(0)" ::: "memory");
        }
    }
    __syncthreads();
}

namespace pg {
constexpr int BM = 256, BK = 64, HALF = 128, HTB = HALF * BK * 2;
__device__ __forceinline__ int lds_byte(int r, int c) { const int st = (r >> 4) * 2 + (c >> 5), rr = r & 15, cc = c & 31, ob = rr * 64 + cc * 2; return st * 1024 + (ob ^ (((ob >> 9) & 1) << 5)); }
__device__ __forceinline__ void stage_rc(int b, int& R, int& C) { const int st = b / 1024, sb = b % 1024, swz = sb ^ (((sb >> 9) & 1) << 5); R = (st >> 1) * 16 + swz / 64; C = (st & 1) * 32 + (swz % 64) / 2; }
__device__ __forceinline__ int perm32(int rho) { const int n = rho >> 4, i = rho & 15; return 8 * (i >> 2) + 4 * n + (i & 3); }
struct Unit { const char* B0; int dB1; int arow, pn, slot; };
__device__ __forceinline__ void lane_rc(int tid, int i, int& R, int& C) { stage_rc(tid * 16 + i * 8192, R, C); }

template <class Epi, class Sched, bool GATHER, bool FP8>
__device__ __forceinline__ void gemm_phase(LAS unsigned char* lds, int wid, const Sched& S, const Epi& E) {
    asm volatile("" : "+s"(wid));
    int lane = lane_id(); asm volatile("" : "+v"(lane));
    const int tid = wid * 64 + lane, wr = wid >> 2, wc = wid & 3, fr = lane & 15, fq = lane >> 4;
    constexpr int NKT = FP8 ? 8 : 16, KSPLIT = NKT / 2;
    constexpr unsigned PITCHA = FP8 ? 1024u : 2048u;
    unsigned voffA[2], voffB[2];
#pragma unroll
    for (int i = 0; i < 2; ++i) { int R, C; stage_rc(tid * 16 + i * 8192, R, C); const int Rb = (R & ~31) + perm32(R & 31); voffA[i] = (unsigned)(R * PITCHA + C * 2); voffB[i] = (unsigned)(Rb * S.pitchB + C * 2); }
    const unsigned hstepB = 128u * (unsigned)S.pitchB;
    constexpr unsigned hstepA = 128u * PITCHA;
    const unsigned ldsw = (unsigned)wid * 1024u;
    const int aoff = lds_byte(wr * 64 + fr, fq * 8), boff = lds_byte(wc * 32 + fr, fq * 8);
#define PG_SA(b, h) (((b) * 2 + (h)) * HTB)
#define PG_SB(b, h) ((4 + (b) * 2 + (h)) * HTB)
#define PG_STAGE_A(bufoff, ptr, half) do { _Pragma("unroll") for (int _i = 0; _i < 2; ++_i) { \
        const char* _src = GATHER ? ((ptr) + ga[half][_i]) : ((ptr) + (half) * hstepA + voffA[_i]); \
        __builtin_amdgcn_global_load_lds((const unsigned*)_src, (LAS unsigned*)(lds + (bufoff) + ldsw + _i * 8192), 16, 0, 0); } } while (0)
#define PG_STAGE_B(bufoff, ptr, half) do { _Pragma("unroll") for (int _i = 0; _i < 2; ++_i) \
        __builtin_amdgcn_global_load_lds((const unsigned*)((ptr) + (half) * hstepB + voffB[_i]), (LAS unsigned*)(lds + (bufoff) + ldsw + _i * 8192), 16, 0, 0); } while (0)
#define PG_LDA(dst, b, h) do { _Pragma("unroll") for (int m = 0; m < 4; ++m) _Pragma("unroll") for (int k = 0; k < 2; ++k) dst[m][k] = *(const LAS bf16x8*)(lds + PG_SA(b, h) + aoff + m * 2048 + k * 1024); } while (0)
#define PG_LDB(dst, b, h) do { _Pragma("unroll") for (int n = 0; n < 2; ++n) _Pragma("unroll") for (int k = 0; k < 2; ++k) dst[n][k] = *(const LAS bf16x8*)(lds + PG_SB(b, h) + boff + n * 2048 + k * 1024); } while (0)
#define PG_MMA(ai, bj, At, Bt) do { __builtin_amdgcn_s_setprio(1); _Pragma("unroll") for (int m = 0; m < 4; ++m) _Pragma("unroll") for (int n = 0; n < 2; ++n) _Pragma("unroll") for (int k = 0; k < 2; ++k) \
        acc[ai][bj][m][n] = __builtin_amdgcn_mfma_f32_16x16x32_bf16(Bt[n][k], At[m][k], acc[ai][bj][m][n], 0, 0, 0); __builtin_amdgcn_s_setprio(0); } while (0)
#define PG_LDA8(dst, b, h) do { _Pragma("unroll") for (int m = 0; m < 4; ++m) { const i32x4 lo_ = *(const LAS i32x4*)(lds + PG_SA(b, h) + aoff + m * 2048), hi_ = *(const LAS i32x4*)(lds + PG_SA(b, h) + aoff + m * 2048 + 1024); dst[m] = __builtin_shufflevector(lo_, hi_, 0, 1, 2, 3, 4, 5, 6, 7); } } while (0)
#define PG_LDB8(dst, b, h) do { _Pragma("unroll") for (int n = 0; n < 2; ++n) { const i32x4 lo_ = *(const LAS i32x4*)(lds + PG_SB(b, h) + boff + n * 2048), hi_ = *(const LAS i32x4*)(lds + PG_SB(b, h) + boff + n * 2048 + 1024); dst[n] = __builtin_shufflevector(lo_, hi_, 0, 1, 2, 3, 4, 5, 6, 7); } } while (0)
#define PG_MMA8(ai, bj, At, Bt) do { __builtin_amdgcn_s_setprio(1); _Pragma("unroll") for (int m = 0; m < 4; ++m) _Pragma("unroll") for (int n = 0; n < 2; ++n) \
        acc[ai][bj][m][n] = __builtin_amdgcn_mfma_scale_f32_16x16x128_f8f6f4(Bt[n], At[m], acc[ai][bj][m][n], 0, 0, 0, 0x7f7f7f7f, 0, 0x7f7f7f7f); __builtin_amdgcn_s_setprio(0); } while (0)
#define PG_WAIT_V(n) asm volatile("s_waitcnt vmcnt(" #n ")" ::: "memory")
#define PG_WAIT_L(n) asm volatile("s_waitcnt lgkmcnt(" #n ")" ::: "memory")
#define PG_WAIT_VS(after_epi) do { if constexpr (Epi::NSTORE == 16) { if (after_epi) asm volatile("s_waitcnt vmcnt(24)" ::: "memory"); else asm volatile("s_waitcnt vmcnt(8)" ::: "memory"); } else asm volatile("s_waitcnt vmcnt(8)" ::: "memory"); } while (0)
#define PG_BAR __builtin_amdgcn_s_barrier()
#define PG_SCHED __builtin_amdgcn_sched_barrier(0)
    Unit cur, nxt; int ui = 0;
    if (!S.next(0, cur)) return;
    f32x4 acc[2][2][4][2];
#pragma unroll
    for (int a = 0; a < 2; ++a)
#pragma unroll
        for (int b = 0; b < 2; ++b)
#pragma unroll
            for (int m = 0; m < 4; ++m)
#pragma unroll
                for (int n = 0; n < 2; ++n) acc[a][b][m][n] = (f32x4){0.f, 0.f, 0.f, 0.f};
    bf16x8 At[4][2], B0[2][2], B1[2][2]; i32x8 At8[4], B08[2], B18[2];
    unsigned ga[2][2] = {{0u, 0u}, {0u, 0u}};
    if constexpr (GATHER) S.aoffs(cur, tid, ga);
    if constexpr (Epi::HAS_MID) E.unit_begin(cur, 0, tid);
    const char* cA = S.abase() + (GATHER ? (size_t)0 : (size_t)cur.arow * (256u * PITCHA));
    PG_STAGE_B(PG_SB(0, 0), cur.B0, 0); PG_STAGE_B(PG_SB(0, 1), cur.B0, 1); PG_STAGE_A(PG_SA(0, 0), cA, 0); PG_STAGE_A(PG_SA(0, 1), cA, 1);
    if (wr == 1) PG_BAR;
    PG_WAIT_V(2); PG_BAR;
    PG_STAGE_B(PG_SB(1, 0), cur.B0 + 128, 0); PG_STAGE_A(PG_SA(1, 0), cA + 128, 0); PG_STAGE_B(PG_SB(1, 1), cur.B0 + 128, 1);
    PG_WAIT_V(6); PG_BAR;
    for (;;) {
        const bool has_next = S.next(ui + 1, nxt);
        if (!has_next) nxt = cur;
        const char* nA = S.abase() + (GATHER ? (size_t)0 : (size_t)nxt.arow * (256u * PITCHA));
#pragma unroll 1
        for (int t = 0; t < NKT; t += 2) {
            const bool last = (t == NKT - 2);
            if constexpr (Epi::HAS_MID) { if (t == KSPLIT) { E.mid(acc, ui & 1, wr, lane_id() & 15); PG_SCHED; } }
            const char* a1 = cA + (t + 1) * 128;
            const char* a2 = last ? nA : cA + (t + 2) * 128; const char* a3 = a2 + 128;
            const char* b2 = last ? nxt.B0 : (cur.B0 + (t + 2 < KSPLIT ? 0 : cur.dB1) + ((t + 2) & (KSPLIT - 1)) * 128);
            const char* b3 = b2 + 128;
            if constexpr (!FP8) {
            const bool aft = (t == 0) && (ui > 0);
            PG_LDB(B0, 0, 0); PG_LDB(B1, 0, 1); PG_SCHED; PG_LDA(At, 0, 0); PG_STAGE_A(PG_SA(1, 1), a1, 1);
            PG_WAIT_VS(aft); PG_WAIT_L(0); PG_BAR; PG_MMA(0, 0, At, B0); PG_MMA(0, 1, At, B1); PG_BAR; PG_SCHED;
            if constexpr (GATHER) { if (last) { S.aoffs(nxt, wid * 64 + lane_id(), ga); PG_SCHED; } }
            PG_LDA(At, 0, 1); PG_STAGE_B(PG_SB(0, 0), b2, 0); PG_STAGE_B(PG_SB(0, 1), b2, 1); PG_STAGE_A(PG_SA(0, 0), a2, 0);
            PG_WAIT_VS(aft); PG_WAIT_L(0); PG_BAR; PG_MMA(1, 0, At, B0); PG_MMA(1, 1, At, B1); PG_BAR; PG_SCHED;
            PG_LDB(B0, 1, 0); PG_LDB(B1, 1, 1); PG_SCHED; PG_LDA(At, 1, 0); PG_STAGE_A(PG_SA(0, 1), a2, 1);
            PG_WAIT_VS(aft); PG_WAIT_L(0); PG_BAR; PG_MMA(0, 0, At, B0); PG_MMA(0, 1, At, B1); PG_BAR; PG_SCHED;
            PG_LDA(At, 1, 1); PG_STAGE_B(PG_SB(1, 0), b3, 0); PG_STAGE_B(PG_SB(1, 1), b3, 1); PG_STAGE_A(PG_SA(1, 0), a3, 0);
            PG_WAIT_V(8); PG_WAIT_L(0); PG_BAR; PG_MMA(1, 0, At, B0); PG_MMA(1, 1, At, B1); PG_BAR; PG_SCHED;
            } else {
            PG_LDB8(B08, 0, 0); PG_LDB8(B18, 0, 1); PG_SCHED; PG_LDA8(At8, 0, 0); PG_STAGE_A(PG_SA(1, 1), a1, 1);
            PG_WAIT_V(8); PG_WAIT_L(0); PG_BAR; PG_MMA8(0, 0, At8, B08); PG_MMA8(0, 1, At8, B18); PG_BAR; PG_SCHED;
            if constexpr (GATHER) { if (last) { S.aoffs(nxt, wid * 64 + lane_id(), ga); PG_SCHED; } }
            PG_LDA8(At8, 0, 1); PG_STAGE_B(PG_SB(0, 0), b2, 0); PG_STAGE_B(PG_SB(0, 1), b2, 1); PG_STAGE_A(PG_SA(0, 0), a2, 0);
            PG_WAIT_V(8); PG_WAIT_L(0); PG_BAR; PG_MMA8(1, 0, At8, B08); PG_MMA8(1, 1, At8, B18); PG_BAR; PG_SCHED;
            PG_LDB8(B08, 1, 0); PG_LDB8(B18, 1, 1); PG_SCHED; PG_LDA8(At8, 1, 0); PG_STAGE_A(PG_SA(0, 1), a2, 1);
            PG_WAIT_V(8); PG_WAIT_L(0); PG_BAR; PG_MMA8(0, 0, At8, B08); PG_MMA8(0, 1, At8, B18); PG_BAR; PG_SCHED;
            PG_LDA8(At8, 1, 1); PG_STAGE_B(PG_SB(1, 0), b3, 0); PG_STAGE_B(PG_SB(1, 1), b3, 1); PG_STAGE_A(PG_SA(1, 0), a3, 0);
            PG_WAIT_V(8); PG_WAIT_L(0); PG_BAR; PG_MMA8(1, 0, At8, B08); PG_MMA8(1, 1, At8, B18); PG_BAR; PG_SCHED;
            }
        }
        if (wr == 0) PG_BAR;
        { const int ln_ = lane_id(); E(acc, cur, ui, wr, wc, ln_ & 15, ln_ >> 4); }
        if (!has_next) break;
#pragma unroll
        for (int a = 0; a < 2; ++a)
#pragma unroll
            for (int b = 0; b < 2; ++b)
#pragma unroll
                for (int m = 0; m < 4; ++m)
#pragma unroll
                    for (int n = 0; n < 2; ++n) acc[a][b][m][n] = (f32x4){0.f, 0.f, 0.f, 0.f};
        cur = nxt; cA = nA; ++ui;
        if constexpr (Epi::HAS_MID) E.unit_begin(cur, ui & 1, wid * 64 + lane_id());
        if (wr == 1) PG_BAR;
    }
    PG_WAIT_V(0);
    PG_BAR;
#undef PG_SA
#undef PG_SB
#undef PG_STAGE_A
#undef PG_STAGE_B
#undef PG_LDA
#undef PG_LDB
#undef PG_MMA
#undef PG_LDA8
#undef PG_LDB8
#undef PG_MMA8
#undef PG_WAIT_V
#undef PG_WAIT_L
#undef PG_BAR
#undef PG_SCHED
}
}

struct Args { const void* in[17]; float* out; unsigned char* ws; int ph_lo, ph_hi; };
__device__ __forceinline__ const void* karg_ld(int byte_off) {
    auto kp = __builtin_amdgcn_kernarg_segment_ptr(); unsigned long long v;
    asm volatile("s_load_dwordx2 %0, %1, %2\n\ts_waitcnt lgkmcnt(0)" : "=s"(v) : "s"(kp), "s"(byte_off) : "memory");
    return (const void*)(GAS const void*)v;
}
#define IN_F(k) ((const float*)karg_ld((k) * 8))
#define IN_I(k) ((const int*)karg_ld((k) * 8))
#define K_OUT() ((float*)karg_ld(17 * 8))
#define K_WS() ((unsigned char*)karg_ld(18 * 8))
struct Frame {
    LAS unsigned char* lds;
    int tid, lane, wave, G, vcu;
    unsigned char* ws;
};

struct DenseSched {
    size_t a_off, b_off; int pitchB, nN, c, G;
    __device__ __forceinline__ const char* abase() const { return (const char*)K_WS() + a_off; }
    __device__ __forceinline__ bool next(int i, pg::Unit& u) const {
        const int nM = T / 256, nwg = nM * nN;
        const long L = (long)i * G + c; if (L >= nwg) return false;
        int wgid = (int)L; { const int q = nwg / 8, r = nwg % 8, xcd = wgid % 8, off = wgid / 8; wgid = (xcd < r ? xcd * (q + 1) : r * (q + 1) + (xcd - r) * q) + off; }
        const int nig = 8 * nN, gid = wgid / nig, fm = gid * 8, gsz = (nM - fm) < 8 ? (nM - fm) : 8;
        u.arow = fm + ((wgid % nig) % gsz); u.pn = (wgid % nig) / gsz; u.slot = 0;
        u.B0 = (const char*)K_WS() + b_off + (size_t)u.pn * 256 * 2048; u.dB1 = 1024; return true;
    }
};
__device__ __forceinline__ void bucket_experts(int bk, int& e_lo, int& e_hi) {
    const int g = bk / 28; int p = bk % 28; int lo = 0;
#pragma unroll
    for (int k = 0; k < 7; ++k) { const int len = 7 - k; if (lo == k && p >= len) { p -= len; lo = k + 1; } }
    e_lo = g * 8 + lo; e_hi = g * 8 + lo + 1 + p;
}
__device__ __forceinline__ int utab_get(int i, int f) { return __builtin_amdgcn_readfirstlane(((volatile LAS int*)LDSP(UNIT_OFF))[i * 4 + f]); }
struct GuSched {
    int pitchB, l, nmine;
    __device__ __forceinline__ const char* abase() const { return (const char*)K_WS() + WS_XF8; }
    __device__ __forceinline__ bool next(int i, pg::Unit& u) const {
        if (i >= nmine) return false;
        const int e = utab_get(i, 0), pn = utab_get(i, 2);
        u.slot = i; u.pn = pn; u.arow = 0;
        u.B0 = (const char*)K_WS() + WS_WGU8 + (((size_t)l * NE + e) * 1024 + (size_t)pn * 256) * 1024; u.dB1 = 512; return true;
    }
    __device__ __forceinline__ void aoffs(const pg::Unit& u, int tid, unsigned (&o)[2][2]) const {
        volatile LAS int* vt = (volatile LAS int*)LDSP(TOK_OFF);
#pragma unroll
        for (int i = 0; i < 2; ++i) { int R, C; pg::lane_rc(tid, i, R, C);
#pragma unroll
            for (int ai = 0; ai < 2; ++ai) { const int tok = vt[u.slot * 256 + ai * 128 + R] & 0x7fffffff; o[ai][i] = (unsigned)(tok * 1024 + C * 2); } }
    }
};
struct DnSched {
    int pitchB, l, nmine;
    __device__ __forceinline__ const char* abase() const { return (const char*)K_WS() + WS_QKV; }
    __device__ __forceinline__ bool next(int i, pg::Unit& u) const {
        if (i >= nmine) return false;
        const int bk = utab_get(i, 0), tg = utab_get(i, 1), pn = utab_get(i, 2);
        int elo, ehi; bucket_experts(bk, elo, ehi);
        u.slot = i; u.pn = pn; u.arow = tg;
        u.B0 = (const char*)K_WS() + WS_WDN8 + (((size_t)l * NE + elo) * 1024 + (size_t)pn * 256) * 512; u.dB1 = (ehi - elo) * 1024 * 512; return true;
    }
    __device__ __forceinline__ void aoffs(const pg::Unit& u, int tid, unsigned (&o)[2][2]) const {
#pragma unroll
        for (int i = 0; i < 2; ++i) { int R, C; pg::lane_rc(tid, i, R, C);
#pragma unroll
            for (int ai = 0; ai < 2; ++ai) o[ai][i] = (unsigned)((u.arow * 256 + ai * 128 + R) * 1024 + C * 2); }
    }
};

struct EpiQKV {
    static constexpr int NSTORE = 0;
    static constexpr bool HAS_MID = false; int l;
    __device__ __forceinline__ void operator()(const f32x4 (&acc)[2][2][4][2], const pg::Unit& u, int ui, int wr, int wc, int fr, int fq) const {
        asm volatile("" : "+v"(fr), "+v"(fq));
        unsigned char* ws = K_WS();
        bf16_t* qkv = (bf16_t*)(ws + WS_QKV); const float* ssq = (const float*)(ws + WS_SSQ2); const unsigned* rope = (const unsigned*)(ws + WS_ROPE);
        const int pm = u.arow, pn = u.pn, hh = pn * 4 + wc, lane = fq * 16 + fr, wid = wr * 4 + wc;
        const bool isq = (hh < 8) || (hh >= 24 && hh < 32);
        const bool isk = (hh >= 8 && hh < 16) || (hh == 32) || (hh == 33);
        const bool normed = isq || isk;
        const int gsel = hh < 8 ? 0 : (hh < 16 ? 1 : (hh < 32 ? 2 : 3));
        const float* gp = (const float*)(ws + WS_GAINS) + (l * 4 + gsel) * 64;
        const float qs = isq ? QSCALE : 1.f;
        const int fa = fq >> 1, fb = fq & 1;
        f32x4 g[2][2];
#pragma unroll
        for (int bj = 0; bj < 2; ++bj)
#pragma unroll
            for (int n = 0; n < 2; ++n) g[bj][n] = *(const f32x4*)(gp + 32 * bj + 16 * fa + 8 * n + 4 * fb) * qs;
        f32x4 sp4[2][4];
#pragma unroll
        for (int ai = 0; ai < 2; ++ai) { const f32x4* sp = (const f32x4*)(ssq + (size_t)(pm * 256 + ai * 128 + wr * 64 + lane) * 16); sp4[ai][0] = sp[0]; sp4[ai][1] = sp[1]; sp4[ai][2] = sp[2]; sp4[ai][3] = sp[3]; }
        u32x4 rp0[4], rp1[4];
        if (normed) {
#pragma unroll
            for (int m = 0; m < 4; ++m) rp0[m] = *(const u32x4*)(rope + (size_t)(fa ? T : pm * 256 + wr * 64 + m * 16 + fr) * 8 + 4 * fb);
        }
        float rxl[2];
#pragma unroll
        for (int ai = 0; ai < 2; ++ai) { const f32x4 s4 = (sp4[ai][0] + sp4[ai][1]) + (sp4[ai][2] + sp4[ai][3]); rxl[ai] = __builtin_amdgcn_rsqf(((s4[0] + s4[1]) + (s4[2] + s4[3])) * (1.f / 1024.f) + EPS); }
#pragma unroll
        for (int ai = 0; ai < 2; ++ai) {
            if (ai == 1 && normed) {
#pragma unroll
                for (int m = 0; m < 4; ++m) rp1[m] = *(const u32x4*)(rope + (size_t)(fa ? T : pm * 256 + 128 + wr * 64 + m * 16 + fr) * 8 + 4 * fb);
            }
            u32x4 (&rp)[4] = ai ? rp1 : rp0;
            float rx[4];
#pragma unroll
            for (int m = 0; m < 4; ++m) rx[m] = __shfl(rxl[ai], m * 16 + fr);
#pragma unroll
            for (int m = 0; m < 4; ++m) {
                const int row = pm * 256 + ai * 128 + wr * 64 + m * 16 + fr;
                const f32x4 a00 = acc[ai][0][m][0], a01 = acc[ai][0][m][1], a10 = acc[ai][1][m][0], a11 = acc[ai][1][m][1];
                f32x4 v00, v01, v10, v11;
                if (normed) {
                    const f32x4 sq = (a00 * a00 + a01 * a01) + (a10 * a10 + a11 * a11);
                    float ss = (sq[0] + sq[1]) + (sq[2] + sq[3]);
                    ss = sum_xor32(sum_xor16(ss));
                    const float sc = rx[m] * __builtin_amdgcn_rsqf(rx[m] * rx[m] * ss * (1.f / 64.f) + EPS);
                    v00 = a00 * (g[0][0] * sc); v01 = a01 * (g[0][1] * sc); v10 = a10 * (g[1][0] * sc); v11 = a11 * (g[1][1] * sc);
#pragma unroll
                    for (int i = 0; i < 4; ++i) { const float c = bflo(rp[m][i]), sn = bfhi(rp[m][i]), x1 = v00[i], x2 = v01[i]; v00[i] = x1 * c - x2 * sn; v01[i] = x2 * c + x1 * sn; }
                } else { v00 = a00 * rx[m]; v01 = a01 * rx[m]; v10 = a10 * rx[m]; v11 = a11 * rx[m]; }
                { LAS unsigned char* stg = LDSP(EPST_OFF) + wid * 2048;
                  { typedef unsigned u32x2 __attribute__((ext_vector_type(2))); LAS unsigned char* sr = stg + fr * 128 + 8 * fb; const int sx = fr & 7;
                    *(LAS u32x2*)(sr + (((2 * fa) ^ sx) << 4)) = (u32x2){pk2(v00[0], v00[1]), pk2(v00[2], v00[3])}; *(LAS u32x2*)(sr + (((2 * fa + 1) ^ sx) << 4)) = (u32x2){pk2(v01[0], v01[1]), pk2(v01[2], v01[3])};
                    *(LAS u32x2*)(sr + (((4 + 2 * fa) ^ sx) << 4)) = (u32x2){pk2(v10[0], v10[1]), pk2(v10[2], v10[3])}; *(LAS u32x2*)(sr + (((5 + 2 * fa) ^ sx) << 4)) = (u32x2){pk2(v11[0], v11[1]), pk2(v11[2], v11[3])}; }
                  LDS_WAIT(); asm volatile("" ::: "memory");
                  const int row0 = pm * 256 + ai * 128 + wr * 64 + m * 16;
                  bf16_t* gp0 = qkv + (((size_t)(row0 >> 13) * 36 + hh) * SEQ + (row0 & (SEQ - 1))) * 64;
#pragma unroll
                  for (int k = 0; k < 2; ++k) { const int r16 = (lane >> 3) + 8 * k, ch = lane & 7; const u32x4 w = *(const LAS u32x4*)(stg + r16 * 128 + ((ch ^ (r16 & 7)) << 4));
                      *(u32x4*)(gp0 + r16 * 64 + ch * 8) = w; }
                  LDS_WAIT(); asm volatile("" ::: "memory"); }
            }
            asm volatile("" ::: "memory");
        }
    }
};
constexpr int NRM_OFF = TOK_OFF;
struct EpiRes {
    static constexpr int NSTORE = 0;
    static constexpr bool HAS_MID = true; int l;
    __device__ __forceinline__ void unit_begin(const pg::Unit& u, int par, int tid) const {
        unsigned char* ws = K_WS();
        const int row = u.arow * 256 + (tid >> 1), side = tid & 1;
        const float* sp = (const float*)(ws + (side ? WS_SSQB : WS_SSQA)) + row;
        float sh[8];
#pragma unroll
        for (int h = 0; h < 8; ++h) sh[h] = sp[(size_t)h * T];
        const float r = __builtin_amdgcn_rsqf((((sh[0] + sh[1]) + (sh[2] + sh[3])) + ((sh[4] + sh[5]) + (sh[6] + sh[7]))) * (1.f / 512.f) + EPS), o = __shfl_xor(r, 1);
        LAS float* tab = (LAS float*)LDSP(NRM_OFF) + par * 512;
        if (side == 0) tab[tid >> 1] = r * __builtin_amdgcn_rcpf(o); else tab[256 + (tid >> 1)] = r;
    }
    __device__ __forceinline__ void mid(f32x4 (&acc)[2][2][4][2], int par, int wr, int fr) const {
        const LAS float* tab = (const LAS float*)LDSP(NRM_OFF) + par * 512;
#pragma unroll
        for (int ai = 0; ai < 2; ++ai)
#pragma unroll
            for (int m = 0; m < 4; ++m) { const float sc = tab[ai * 128 + wr * 64 + m * 16 + fr];
#pragma unroll
                for (int bj = 0; bj < 2; ++bj)
#pragma unroll
                    for (int n = 0; n < 2; ++n) acc[ai][bj][m][n] *= sc; }
    }
    __device__ __forceinline__ void operator()(const f32x4 (&acc)[2][2][4][2], const pg::Unit& u, int ui, int wr, int wc, int fr, int fq) const {
        asm volatile("" : "+v"(fr), "+v"(fq));
        unsigned char* ws = K_WS(); const bf16_t* xnb = (const bf16_t*)(ws + WS_XN);
        bf16_t* xb = (bf16_t*)(ws + WS_XB1); float* ssq = (float*)(ws + WS_SSQ1); unsigned char* xf8 = ws + WS_XF8;
        const LAS float* rbt = (const LAS float*)LDSP(NRM_OFF) + (ui & 1) * 512 + 256;
        const int pm = u.arow, pn = u.pn;
#pragma unroll
        for (int ai = 0; ai < 2; ++ai) {
            f32x4 xv[4][2][2];
#pragma unroll
            for (int m = 0; m < 4; ++m)
#pragma unroll
                for (int bj = 0; bj < 2; ++bj) { const size_t off = (size_t)(pm * 256 + ai * 128 + wr * 64 + m * 16 + fr) * D + pn * 256 + 128 * bj + 32 * wc + 8 * fq;
                    { const u32x4 w = *(const u32x4*)(xnb + off); xv[m][bj][0] = (f32x4){bflo(w.x), bfhi(w.x), bflo(w.y), bfhi(w.y)}; xv[m][bj][1] = (f32x4){bflo(w.z), bfhi(w.z), bflo(w.w), bfhi(w.w)}; } }
            float keep = 0.f;
#pragma unroll
            for (int m = 0; m < 4; ++m) {
                const int row = pm * 256 + ai * 128 + wr * 64 + m * 16 + fr; float ss = 0.f;
                const float rb = rbt[ai * 128 + wr * 64 + m * 16 + fr];
#pragma unroll
                for (int bj = 0; bj < 2; ++bj) {
                    const size_t off = (size_t)row * D + pn * 256 + 128 * bj + 32 * wc + 8 * fq;
                    const f32x4 o0 = xv[m][bj][0] + acc[ai][bj][m][0] * rb, o1 = xv[m][bj][1] + acc[ai][bj][m][1] * rb;
                    *(u32x4*)(xb + off) = pack8(o0, o1);
                    { typedef unsigned u32x2 __attribute__((ext_vector_type(2))); u32x2 w8; w8.x = pk4_fp8(o0[0], o0[1], o0[2], o0[3]); w8.y = pk4_fp8(o1[0], o1[1], o1[2], o1[3]); *(u32x2*)(xf8 + off) = w8; }
                    { const f32x4 q4 = o0 * o0 + o1 * o1; ss += (q4[0] + q4[1]) + (q4[2] + q4[3]); }
                }
                ss += __shfl_xor(ss, 16); ss += __shfl_xor(ss, 32);
                keep = (fq == m) ? ss : keep;
            }
            ssq[(size_t)(pn * 4 + wc) * T + pm * 256 + ai * 128 + wr * 64 + fq * 16 + fr] = keep;
            asm volatile("" ::: "memory");
        }
    }
};
struct EpiGU {
    static constexpr int NSTORE = 0;
    static constexpr bool HAS_MID = false; int l;
    __device__ __forceinline__ void operator()(const f32x4 (&acc)[2][2][4][2], const pg::Unit& u, int ui, int wr, int wc, int fr, int fq) const {
        asm volatile("" : "+v"(fr), "+v"(fq));
        unsigned char* ws = K_WS();
        unsigned char* abuf = ws + WS_QKV; const f32x4* tokinfo = (const f32x4*)(ws + WS_TOKINFO);
        volatile LAS int* toktab = (volatile LAS int*)LDSP(TOK_OFF); volatile LAS int* tst = (volatile LAS int*)LDSP(TST_OFF);
        const int slot = u.slot, pn = u.pn, rows = utab_get(slot, 3);
#pragma unroll
        for (int ai = 0; ai < 2; ++ai) {
            f32x4 inf[4]; int ent[4]; unsigned trw[4];
#pragma unroll
            for (int m = 0; m < 4; ++m) { ent[m] = toktab[slot * 256 + ai * 128 + wr * 64 + m * 16 + fr]; inf[m] = tokinfo[ent[m] & 0x7fffffff]; trw[m] = ((const unsigned*)(ws + WS_TOKROW))[ent[m] & 0x7fffffff]; }
#pragma unroll
            for (int m = 0; m < 4; ++m) {
                const int rr = ai * 128 + wr * 64 + m * 16 + fr;
                const bool ishi = ent[m] < 0;
                const unsigned tr = trw[m];
                const size_t prow = (size_t)tst[(tr >> 16) & 127] * 256 + (tr & 0xffffu);
                const float rs = inf[m][0] * (1.f / SW_GU), gs = (ishi ? inf[m][2] : inf[m][1]) * SA_A;
                const float rsn = -rs * LOG2E, cc = gs * rs * rs;
                f32x4 o[2];
#pragma unroll
                for (int n = 0; n < 2; ++n) {
                    const f32x4 g4 = acc[ai][0][m][n], u4 = acc[ai][1][m][n];
                    f32x4 e4 = g4 * rsn;
#pragma unroll
                    for (int i = 0; i < 4; ++i) e4[i] = __builtin_amdgcn_exp2f(e4[i]);
                    e4 = e4 + 1.f;
#pragma unroll
                    for (int i = 0; i < 4; ++i) e4[i] = __builtin_amdgcn_rcpf(e4[i]);
                    o[n] = ((g4 * u4) * cc) * e4;
                }
                if (rr < rows) { typedef unsigned u32x2 __attribute__((ext_vector_type(2))); u32x2 w8; w8.x = pk4_fp8(o[0][0], o[0][1], o[0][2], o[0][3]); w8.y = pk4_fp8(o[1][0], o[1][1], o[1][2], o[1][3]);
                  __builtin_nontemporal_store(w8, (u32x2*)(abuf + prow * 1024 + (ishi ? 512 : 0) + pn * 128 + 32 * wc + 8 * fq)); }
            }
            asm volatile("" ::: "memory");
        }
    }
};
struct EpiDown {
    static constexpr int NSTORE = 0;
    static constexpr bool HAS_MID = false; int l;
    __device__ __forceinline__ void operator()(const f32x4 (&acc)[2][2][4][2], const pg::Unit& u, int ui, int wr, int wc, int fr, int fq) const {
        asm volatile("" : "+v"(fr), "+v"(fq));
        unsigned char* ws = K_WS(); float* xout = K_OUT();
        const bf16_t* xb = (const bf16_t*)(ws + WS_XB1); bf16_t* xn = (bf16_t*)(ws + WS_XN); float* ssq = (float*)(ws + WS_SSQ2);
        const bool lastl = (l + 1 == DEPTH);
        volatile LAS int* toktab = (volatile LAS int*)LDSP(TOK_OFF);
        const int slot = u.slot, pn = u.pn, rows = utab_get(slot, 3);
#pragma unroll
        for (int ai = 0; ai < 2; ++ai) {
            int tok[4]; u32x4 xv[4][2];
#pragma unroll
            for (int m = 0; m < 4; ++m) { const int rr = ai * 128 + wr * 64 + m * 16 + fr; tok[m] = toktab[slot * 256 + rr];
#pragma unroll
                for (int bj = 0; bj < 2; ++bj) xv[m][bj] = *(const u32x4*)(xb + (size_t)tok[m] * D + pn * 256 + 128 * bj + 32 * wc + 8 * fq); }
#pragma unroll
            for (int m = 0; m < 4; ++m) {
                const int rr = ai * 128 + wr * 64 + m * 16 + fr;
                const bool ok = rr < rows; float ss = 0.f;
#pragma unroll
                for (int bj = 0; bj < 2; ++bj) {
                    const size_t off = (size_t)tok[m] * D + pn * 256 + 128 * bj + 32 * wc + 8 * fq;
                    const u32x4 w = xv[m][bj];
                    const f32x4 o0 = acc[ai][bj][m][0] * (1.f / (SW_DN * SA_A)) + (f32x4){bflo(w.x), bfhi(w.x), bflo(w.y), bfhi(w.y)}, o1 = acc[ai][bj][m][1] * (1.f / (SW_DN * SA_A)) + (f32x4){bflo(w.z), bfhi(w.z), bflo(w.w), bfhi(w.w)};
                    if (ok) {
                        if (lastl) { __builtin_nontemporal_store(o0, (f32x4*)(xout + off)); __builtin_nontemporal_store(o1, (f32x4*)(xout + off + 4)); }
                        else *(u32x4*)(xn + off) = pack8(o0, o1);
                    }
                    { const f32x4 q4 = o0 * o0 + o1 * o1; ss += (q4[0] + q4[1]) + (q4[2] + q4[3]); }
                }
                ss += __shfl_xor(ss, 16); ss += __shfl_xor(ss, 32);
                if (ok && !lastl && fq == 0) ssq[(size_t)tok[m] * 16 + pn * 4 + wc] = ss;
            }
            asm volatile("" ::: "memory");
        }
    }
};

__constant__ double INV_FREQ[8] = {1.0, 0.19392274474868576, 0.03760603093086393, 0.007292664737217109, 0.001414213562373095, 0.0002742481756762073, 5.318295896944988e-05, 1.031338537721246e-05};
__device__ __forceinline__ int dstrow(int mode, int n) {
    if (mode == 1) { const int pn = n >> 8, w = n & 255, d = w & 63; return (pn << 8) + 128 * (d >> 5) + 32 * (w >> 6) + 16 * ((d >> 4) & 1) + 8 * ((d >> 2) & 1) + 4 * ((d >> 3) & 1) + (d & 3); }
    if (mode == 2) { const int bj = n >> 9, w = n & 511; return 256 * (w >> 7) + 128 * bj + (w & 127); }
    return n;
}
__device__ __forceinline__ void p0_item(const float* W, int N, bf16_t* WT, int pitch, const float* g, int mode, LAS float* sT, int item, int lane) {
    const int nblk = N / 64, kb = item / nblk, nb = item % nblk, k0 = 64 * kb, n0 = 64 * nb;
    const int kl = lane >> 4, n4 = lane & 15;
    f32x4 v[16];
#pragma unroll
    for (int i = 0; i < 16; ++i) v[i] = __builtin_nontemporal_load((const GAS f32x4*)(W + (size_t)(k0 + 4 * i + kl) * N + n0 + 4 * n4));
#pragma unroll
    for (int i = 0; i < 16; ++i) { const int k = 4 * i + kl; const float gv = g ? g[k0 + k] : 1.f;
#pragma unroll
        for (int e = 0; e < 4; ++e) sT[(4 * n4 + e) * 65 + k] = v[i][e] * gv; }
    LDS_WAIT(); asm volatile("" ::: "memory");
    const int c = lane & 7;
#pragma unroll
    for (int j = 0; j < 8; ++j) { const int n = (lane >> 3) + 8 * j; const LAS float* sp = sT + n * 65 + 8 * c;
        u32x4 o; o.x = pk2(sp[0], sp[1]); o.y = pk2(sp[2], sp[3]); o.z = pk2(sp[4], sp[5]); o.w = pk2(sp[6], sp[7]);
        *(GAS u32x4*)(WT + (size_t)dstrow(mode, n0 + n) * pitch + k0 + 8 * c) = o; }
    LDS_WAIT(); asm volatile("" ::: "memory");
}
__device__ __forceinline__ void p0_item8(const float* W, int N, unsigned char* WT, int pitch, const float* g, float scale, int mode, LAS float* sT, int item, int lane) {
    const int nblk = N / 64, kb = item / nblk, nb = item % nblk, k0 = 64 * kb, n0 = 64 * nb;
    const int kl = lane >> 4, n4 = lane & 15;
    f32x4 v[16];
#pragma unroll
    for (int i = 0; i < 16; ++i) v[i] = __builtin_nontemporal_load((const GAS f32x4*)(W + (size_t)(k0 + 4 * i + kl) * N + n0 + 4 * n4));
#pragma unroll
    for (int i = 0; i < 16; ++i) { const int k = 4 * i + kl; const float gv = (g ? g[k0 + k] : 1.f) * scale;
#pragma unroll
        for (int e = 0; e < 4; ++e) sT[(4 * n4 + e) * 65 + k] = v[i][e] * gv; }
    LDS_WAIT(); asm volatile("" ::: "memory");
    const int c = lane & 3;
#pragma unroll
    for (int j = 0; j < 4; ++j) { const int n = (lane >> 2) + 16 * j; const LAS float* sp = sT + n * 65 + 16 * c;
        u32x4 o; o.x = pk4_fp8(sp[0], sp[1], sp[2], sp[3]); o.y = pk4_fp8(sp[4], sp[5], sp[6], sp[7]); o.z = pk4_fp8(sp[8], sp[9], sp[10], sp[11]); o.w = pk4_fp8(sp[12], sp[13], sp[14], sp[15]);
        __builtin_nontemporal_store(o, (GAS u32x4*)(WT + (size_t)dstrow(mode, n0 + n) * pitch + k0 + 16 * c)); }
    LDS_WAIT(); asm volatile("" ::: "memory");
}
__device__ __forceinline__ void p0_prologue(Frame F) {
    asm volatile("" : "+s"(F.G), "+s"(F.vcu), "+s"(F.wave)); F.lane = lane_id(); asm volatile("" : "+v"(F.lane)); F.tid = F.wave * 64 + F.lane;
    LAS float* scr = (LAS float*)(F.lds + F.wave * 16640);
    const int gw = F.vcu * NWAVES + F.wave, NGW = F.G * NWAVES;
    constexpr int I_IN = 16 * 36, I_OUT = 16 * 16, I_GU = 16 * 16, I_DN = 8 * 16;
    constexpr int N_IN = DEPTH * I_IN, N_OUT = DEPTH * I_OUT, N_GU = DEPTH * NE * I_GU, N_DN = DEPTH * NE * I_DN;
    unsigned char* ws = K_WS();
    bf16_t* WIN = (bf16_t*)(ws + WS_WIN); bf16_t* WOUT = (bf16_t*)(ws + WS_WOUT); unsigned char* WGU8 = ws + WS_WGU8; unsigned char* WDN8 = ws + WS_WDN8;
    for (int it = gw; it < N_IN + N_OUT + N_GU + N_DN; it += NGW) {
        int r = it;
        if (r < N_IN) { const int l = r / I_IN; p0_item(IN_F(3) + (size_t)l * D * PW, PW, WIN + (size_t)l * PW * D, D, IN_F(2) + l * D, 1, scr, r % I_IN, F.lane); continue; } r -= N_IN;
        if (r < N_OUT) { const int l = r / I_OUT; const int kb = (r % I_OUT) / 16; const float* gg = kb < 8 ? IN_F(9) + l * 512 : IN_F(10) + l * 512 - 512;
            p0_item(IN_F(11) + (size_t)l * D * D, D, WOUT + (size_t)l * D * D, D, gg, 0, scr, r % I_OUT, F.lane); continue; } r -= N_OUT;
        if (r < N_GU) { const int le = r / I_GU; p0_item8(IN_F(15) + (size_t)le * D * 1024, 1024, WGU8 + (size_t)le * 1024 * D, D, IN_F(12) + (le / NE) * D, SW_GU, 2, scr, r % I_GU, F.lane); continue; } r -= N_GU;
        { const int le = r / I_DN; p0_item8(IN_F(16) + (size_t)le * DE * D, D, WDN8 + (size_t)le * D * DE, DE, nullptr, SW_DN, 0, scr, r % I_DN, F.lane); }
    }
    bf16_t* WR = (bf16_t*)(ws + WS_WR);
    for (int idx = gw * 64 + F.lane; idx < DEPTH * 64 * D; idx += NGW * 64) {
        const int l = idx / (64 * D), n = (idx / D) % 64, k = idx % D;
        float v = 0.f;
        if (n < 32) v = IN_F(14)[((size_t)l * D + k) * NE + n]; else if (n < 36) v = IN_F(13)[((size_t)l * D + k) * 4 + (n - 32)];
        WR[idx] = (bf16_t)f2bf(v * IN_F(12)[l * D + k]);
    }
    if (gw == 0) { float* gains = (float*)(ws + WS_GAINS);
        for (int idx = F.lane; idx < DEPTH * 4 * 64; idx += 64) { const int l = idx / 256, w = (idx / 64) % 4, d = idx % 64; const float* g0 = IN_F(4); const float* g1 = IN_F(5); const float* g2 = IN_F(6); const float* g3 = IN_F(7);
            gains[idx] = (w == 0 ? g0 : (w == 1 ? g1 : (w == 2 ? g2 : g3)))[l * HD + d]; } }
    unsigned* rope = (unsigned*)(ws + WS_ROPE);
    if (gw == 1 && F.lane < 8) rope[(size_t)T * 8 + F.lane] = 0x00003F80u;
    for (int idx = gw * 64 + F.lane; idx < T * 8; idx += NGW * 64) {
        const int t = idx >> 3, i = idx & 7;
        const double ang = (double)IN_I(1)[t] * INV_FREQ[i];
        const double red = ang - 6.283185307179586476925 * __builtin_rint(ang * 0.15915494309189533577);
        const float rf = (float)red;
        rope[idx] = pk2(cosf(rf), sinf(rf));
    }
    bf16_t* XN = (bf16_t*)(ws + WS_XN); float* ssq2 = (float*)(ws + WS_SSQ2);
    for (int m = gw; m < T; m += 4 * NGW) {
        f32x4 v[4][4]; float sq[4];
#pragma unroll
        for (int r = 0; r < 4; ++r) { const int mr = m + r * NGW < T ? m + r * NGW : m; const GAS f32x4* xr = (const GAS f32x4*)(IN_F(0) + (size_t)mr * D) + F.lane;
#pragma unroll
            for (int j = 0; j < 4; ++j) v[r][j] = __builtin_nontemporal_load(xr + 64 * j); }
#pragma unroll
        for (int r = 0; r < 4; ++r) { float s = 0.f;
#pragma unroll
            for (int j = 0; j < 4; ++j) s += (v[r][j].x * v[r][j].x + v[r][j].y * v[r][j].y) + (v[r][j].z * v[r][j].z + v[r][j].w * v[r][j].w);
            sq[r] = wave_sum(s); }
#pragma unroll
        for (int r = 0; r < 4; ++r) { const int mr = m + r * NGW; if (mr < T) {
            GAS unsigned long long* o8 = (GAS unsigned long long*)(XN + (size_t)mr * D) + F.lane;
#pragma unroll
            for (int j = 0; j < 4; ++j) o8[64 * j] = (unsigned long long)pk2(v[r][j].x, v[r][j].y) | ((unsigned long long)pk2(v[r][j].z, v[r][j].w) << 32);
            if (F.lane < 16) ssq2[(size_t)mr * 16 + F.lane] = (F.lane == 0) ? sq[r] : 0.f; } }
    }
}

__device__ __forceinline__ void gload16(u32x4& dst, const void* p) { asm volatile("global_load_dwordx4 %0, %1, off" : "=v"(dst) : "v"(p) : "memory"); }
typedef short s16x4 __attribute__((ext_vector_type(4)));
__device__ __forceinline__ s16x4 vtr(const LAS unsigned char* p) { return __builtin_bit_cast(s16x4, __builtin_amdgcn_ds_read_tr16_b64_v4i16((LAS s16x4*)p)); }
constexpr int AT_OST = 98560, AT_WSF = AT_OST + 8 * 4096;
static_assert(AT_WSF + 8 * 256 <= TOK_OFF + MAXU * 256 * 4, "attention LDS scratch");
struct AtU { int b, h, dil, res, m0, br; };
__device__ __forceinline__ AtU at_decode_a(int u, int pass) {
    AtU r; const int idx = u & 31, bh = pass ? (u >> 5) : (u >> 6); r.br = pass ? 0 : 1 + ((u >> 5) & 1); r.h = bh & 7; r.b = bh >> 3;
    r.dil = r.br == 0 ? 1 : (r.br == 1 ? 4 : 16);
    r.res = r.br == 0 ? 0 : (r.br == 1 ? (idx >> 3) : (idx >> 1)); r.m0 = 256 * (r.br == 0 ? idx : (r.br == 1 ? (idx & 7) : (idx & 1)));
    return r;
}
__device__ __forceinline__ AtU at_decode_b(int v) { AtU r; r.m0 = 64 * (v & 127); r.h = (v >> 7) & 1; r.b = v >> 8; r.dil = 1; r.res = 0; r.br = 3; return r; }
template <int NK, bool ISB>
__device__ __forceinline__ void at_load(const Frame& F, const AtU& u, u32x4 (&kr)[NK * 8 / NTHREADS], u32x4 (&vr)[NK * 8 / NTHREADS]) {
    const bf16_t* QKV = (const bf16_t*)(F.ws + WS_QKV);
    const bf16_t* Kp = QKV + ((size_t)u.b * 36 + (ISB ? 32 + u.h : 8 + u.h)) * SEQ * 64; const bf16_t* Vp = QKV + ((size_t)u.b * 36 + (ISB ? 34 + u.h : 16 + u.h)) * SEQ * 64;
#pragma unroll
    for (int j = 0; j < NK * 8 / NTHREADS; ++j) {
        const int p = F.tid + j * NTHREADS, key = p >> 3, ch = p & 7, m = u.m0 - 128 + key, mc = m < 0 ? 0 : m;
        const size_t o = (size_t)(mc * u.dil + u.res) * 64 + ch * 8; gload16(kr[j], Kp + o); gload16(vr[j], Vp + o);
    }
}
template <bool ISB>
__device__ __forceinline__ void at_load_q(const Frame& F, const AtU& u, u32x4 (&qf)[4]) {
    const bf16_t* QKV = (const bf16_t*)(F.ws + WS_QKV);
    const int sub = ISB ? (F.wave & 1) : F.wave, qhead = ISB ? (u.h * 4 + (F.wave >> 1)) : u.h;
    const bf16_t* qp = QKV + (((size_t)u.b * 36 + (ISB ? 24 + qhead : qhead)) * SEQ + (size_t)(u.m0 + 32 * sub + (F.lane & 31)) * u.dil + u.res) * 64 + (F.lane >> 5) * 8;
#pragma unroll
    for (int s = 0; s < 4; ++s) gload16(qf[s], qp + s * 16);
}
template <int N>
__device__ __forceinline__ void at_wait_all(u32x4 (&kr)[N], u32x4 (&vr)[N], u32x4 (&q)[4]) {
    (void)kr; (void)vr; (void)q;
    __builtin_amdgcn_sched_barrier(0); asm volatile("s_waitcnt vmcnt(0)" ::: "memory"); __builtin_amdgcn_sched_barrier(0);
}
template <int NK>
__device__ __forceinline__ void at_store(const Frame& F, const u32x4 (&kr)[NK * 8 / NTHREADS], const u32x4 (&vr)[NK * 8 / NTHREADS]) {
    constexpr int KCS = NK * 16 + 16, VDS = NK * 64 + 64, VB = 8 * KCS;
#pragma unroll
    for (int j = 0; j < NK * 8 / NTHREADS; ++j) {
        const int p = F.tid + j * NTHREADS, key = p >> 3, ch = p & 7;
        *(LAS u32x4*)(F.lds + ch * KCS + key * 16) = kr[j];
        *(LAS u32x4*)(F.lds + VB + (ch >> 2) * VDS + key * 64 + (ch & 3) * 16) = vr[j];
    }
}
template <int NK, bool ISB>
__device__ __forceinline__ void at_compute(const Frame& F, int l, const AtU& u, u32x4 (&qr)[4], u32x4 (&kr)[NK * 8 / NTHREADS], u32x4 (&vr)[NK * 8 / NTHREADS], bool has_next, const AtU& un, float sinkv) {
    constexpr int KCS = NK * 16 + 16, VDS = NK * 64 + 64;
    constexpr int KB = 0, VB = 8 * KCS;
    static_assert(VB + 2 * VDS <= AT_OST, "attention LDS image");
    unsigned char* ws = F.ws;
    LAS unsigned char* lds = F.lds;
    const int lane = F.lane, w = F.wave, qq = lane & 31, hi = lane >> 5;
    const int mchunk0 = u.m0, dil = u.dil, res = u.res, br = u.br, h = u.h;
    const size_t rowb = (size_t)u.b * SEQ;
    const int sub = ISB ? (w & 1) : w;
    const int qhead = ISB ? (h * 4 + (w >> 1)) : h;
    const int mq = mchunk0 + 32 * sub + qq;
    const size_t qrow = rowb + (size_t)mq * dil + res;
    f32x16 p[5];
    const int t0 = mchunk0 + 32 * sub - 128;
    const LAS unsigned char* kp0 = lds + KB + hi * KCS + (sub * 32 + qq) * 16;
    const bf16x8 q0 = __builtin_bit_cast(bf16x8, qr[0]), q1 = __builtin_bit_cast(bf16x8, qr[1]), q2 = __builtin_bit_cast(bf16x8, qr[2]), q3 = __builtin_bit_cast(bf16x8, qr[3]);
#define AT_KF(dst, j) do { _Pragma("unroll") for (int s_ = 0; s_ < 4; ++s_) dst[s_] = *(const LAS bf16x8*)(kp0 + (j) * 512 + 2 * s_ * KCS); } while (0)
    {
        bf16x8 ka[4], kb[4];
        AT_KF(ka, 0); AT_KF(kb, 1); __builtin_amdgcn_sched_barrier(0);
        f32x16 a0 = {}, a1 = {};
        a0 = __builtin_amdgcn_mfma_f32_32x32x16_bf16(ka[0], q0, a0, 0, 0, 0); a1 = __builtin_amdgcn_mfma_f32_32x32x16_bf16(kb[0], q0, a1, 0, 0, 0);
        a0 = __builtin_amdgcn_mfma_f32_32x32x16_bf16(ka[1], q1, a0, 0, 0, 0); a1 = __builtin_amdgcn_mfma_f32_32x32x16_bf16(kb[1], q1, a1, 0, 0, 0);
        a0 = __builtin_amdgcn_mfma_f32_32x32x16_bf16(ka[2], q2, a0, 0, 0, 0); a1 = __builtin_amdgcn_mfma_f32_32x32x16_bf16(kb[2], q2, a1, 0, 0, 0);
        a0 = __builtin_amdgcn_mfma_f32_32x32x16_bf16(ka[3], q3, a0, 0, 0, 0); a1 = __builtin_amdgcn_mfma_f32_32x32x16_bf16(kb[3], q3, a1, 0, 0, 0);
        AT_KF(ka, 2); AT_KF(kb, 3); __builtin_amdgcn_sched_barrier(0);
        p[0] = a0; p[1] = a1;
        f32x16 a2 = {}, a3 = {};
        a2 = __builtin_amdgcn_mfma_f32_32x32x16_bf16(ka[0], q0, a2, 0, 0, 0); a3 = __builtin_amdgcn_mfma_f32_32x32x16_bf16(kb[0], q0, a3, 0, 0, 0);
        a2 = __builtin_amdgcn_mfma_f32_32x32x16_bf16(ka[1], q1, a2, 0, 0, 0); a3 = __builtin_amdgcn_mfma_f32_32x32x16_bf16(kb[1], q1, a3, 0, 0, 0);
        a2 = __builtin_amdgcn_mfma_f32_32x32x16_bf16(ka[2], q2, a2, 0, 0, 0); a3 = __builtin_amdgcn_mfma_f32_32x32x16_bf16(kb[2], q2, a3, 0, 0, 0);
        a2 = __builtin_amdgcn_mfma_f32_32x32x16_bf16(ka[3], q3, a2, 0, 0, 0); a3 = __builtin_amdgcn_mfma_f32_32x32x16_bf16(kb[3], q3, a3, 0, 0, 0);
        AT_KF(ka, 4); __builtin_amdgcn_sched_barrier(0);
        p[2] = a2; p[3] = a3;
        f32x16 a4 = {};
        a4 = __builtin_amdgcn_mfma_f32_32x32x16_bf16(ka[0], q0, a4, 0, 0, 0); a4 = __builtin_amdgcn_mfma_f32_32x32x16_bf16(ka[1], q1, a4, 0, 0, 0);
        a4 = __builtin_amdgcn_mfma_f32_32x32x16_bf16(ka[2], q2, a4, 0, 0, 0); a4 = __builtin_amdgcn_mfma_f32_32x32x16_bf16(ka[3], q3, a4, 0, 0, 0);
        p[4] = a4;
    }
#undef AT_KF
    __builtin_amdgcn_sched_barrier(0);
    if (has_next) at_load_q<ISB>(F, un, qr);
#pragma unroll
    for (int r = 0; r < 16; ++r) { const int kk = (r & 3) + 8 * (r >> 2) + 4 * hi;
        if (ISB ? (kk <= qq) : (kk < qq)) p[0][r] = -INFINITY;
        if (kk > qq) p[4][r] = -INFINITY; }
    if (t0 < 0) {
        asm volatile("");
#pragma unroll
        for (int r = 0; r < 16; ++r) { p[0][r] = -INFINITY; if (t0 + 32 < 0) p[1][r] = -INFINITY; if (t0 + 64 < 0) p[2][r] = -INFINITY; if (t0 + 96 < 0) p[3][r] = -INFINITY; }
    }
    float m0 = p[0][0], m1 = p[2][0], m2 = p[4][0], m3 = p[4][1];
#pragma unroll
    for (int r = 0; r < 16; ++r) { if (r) { m0 = vmax3(m0, p[0][r], p[1][r]); m1 = vmax3(m1, p[2][r], p[3][r]); } else { m0 = vmax3(m0, m0, p[1][0]); m1 = vmax3(m1, m1, p[3][0]); } }
#pragma unroll
    for (int r = 2; r < 16; r += 2) { m2 = vmax3(m2, m2, p[4][r]); m3 = vmax3(m3, m3, p[4][r + 1]); }
    float mx = vmax3(m0, m1, vmax3(m2, m2, m3));
    mx = fmaxf(mx, __shfl_xor(mx, 32));
    float sink2 = 0.f;
    if (ISB) { sink2 = sinkv; mx = fmaxf(mx, sink2); }
    f32x16 sacc = {};
    f32x2_t nmx2; { const float nm = -mx; nmx2 = (f32x2_t){nm, nm}; }
#pragma unroll
    for (int j = 0; j < 5; ++j) {
#pragma unroll
        for (int r = 0; r < 16; r += 2) { f32x2_t d2 = {p[j][r], p[j][r + 1]}, e2; asm("v_pk_add_f32 %0, %1, %2" : "=v"(e2) : "v"(d2), "v"(nmx2));
            p[j][r] = __builtin_amdgcn_exp2f(e2[0]); p[j][r + 1] = __builtin_amdgcn_exp2f(e2[1]); }
        sacc += p[j]; }
    float ls = (((sacc[0] + sacc[1]) + (sacc[2] + sacc[3])) + ((sacc[4] + sacc[5]) + (sacc[6] + sacc[7]))) + (((sacc[8] + sacc[9]) + (sacc[10] + sacc[11])) + ((sacc[12] + sacc[13]) + (sacc[14] + sacc[15])));
    ls += __shfl_xor(ls, 32);
    if (ISB) ls += __builtin_amdgcn_exp2f(sink2 - mx);
    f32x16 o0 = {}, o1 = {};
    const LAS unsigned char* vp = lds + VB + ((lane >> 4) & 1) * 32 + (lane & 3) * 8 + (4 * hi + ((lane & 15) >> 2)) * 64 + sub * 2048;
#pragma unroll
    for (int j = 0; j < 5; ++j) {
        s16x4 va[2][4];
#pragma unroll
        for (int s2_ = 0; s2_ < 2; ++s2_) { const LAS unsigned char* vk = vp + (j * 32 + 16 * s2_) * 64; va[s2_][0] = vtr(vk); va[s2_][1] = vtr(vk + 512); va[s2_][2] = vtr(vk + VDS); va[s2_][3] = vtr(vk + VDS + 512); }
        bf16x8 pf[2];
#pragma unroll
        for (int s2_ = 0; s2_ < 2; ++s2_) { u32x4 pw; pw.x = pk2(p[j][8 * s2_ + 0], p[j][8 * s2_ + 1]); pw.y = pk2(p[j][8 * s2_ + 2], p[j][8 * s2_ + 3]); pw.z = pk2(p[j][8 * s2_ + 4], p[j][8 * s2_ + 5]); pw.w = pk2(p[j][8 * s2_ + 6], p[j][8 * s2_ + 7]); pf[s2_] = __builtin_bit_cast(bf16x8, pw); }
#pragma unroll
        for (int s2_ = 0; s2_ < 2; ++s2_) {
            const bf16x8 vf0 = (bf16x8){va[s2_][0][0], va[s2_][0][1], va[s2_][0][2], va[s2_][0][3], va[s2_][1][0], va[s2_][1][1], va[s2_][1][2], va[s2_][1][3]};
            const bf16x8 vf1 = (bf16x8){va[s2_][2][0], va[s2_][2][1], va[s2_][2][2], va[s2_][2][3], va[s2_][3][0], va[s2_][3][1], va[s2_][3][2], va[s2_][3][3]};
            o0 = __builtin_amdgcn_mfma_f32_32x32x16_bf16(pf[s2_], vf0, o0, 0, 0, 0);
            o1 = __builtin_amdgcn_mfma_f32_32x32x16_bf16(pf[s2_], vf1, o1, 0, 0, 0);
        }
    }
    at_wait_all<NK * 8 / NTHREADS>(kr, vr, qr);
    const int ch = lane & 7;
    u32x4 v1[4], v2[4]; float l1[4], l2[4];
    if (!ISB && br == 0) {
        const bf16_t* O1 = (const bf16_t*)(ws + WS_OBR); const bf16_t* O2 = O1 + (size_t)T * 512; const float* L1 = (const float*)(ws + WS_LSE); const float* L2 = L1 + (size_t)T * 8;
#pragma unroll
        for (int i = 0; i < 4; ++i) { const int sq = mchunk0 + 32 * sub + i * 8 + (lane >> 3);
            v1[i] = *(const u32x4*)(O1 + ((size_t)((u.b * 8 + h) * 4 + (sq & 3)) * (SEQ / 4) + (sq >> 2)) * 64 + ch * 8); v2[i] = *(const u32x4*)(O2 + ((size_t)((u.b * 8 + h) * 16 + (sq & 15)) * (SEQ / 16) + (sq >> 4)) * 64 + ch * 8);
            l1[i] = L1[(size_t)((u.b * 8 + h) * 4 + (sq & 3)) * (SEQ / 4) + (sq >> 2)]; l2[i] = L2[(size_t)((u.b * 8 + h) * 16 + (sq & 15)) * (SEQ / 16) + (sq >> 4)]; }
    }
    LAS float* wsf = (LAS float*)(lds + AT_WSF) + w * 64;
    if (hi == 0) { wsf[qq] = __builtin_amdgcn_rcpf(ls); wsf[32 + qq] = mx + __builtin_amdgcn_logf(ls); }
    LDS_WAIT(); asm volatile("" ::: "memory");
    LAS unsigned* stg = (LAS unsigned*)(lds + AT_OST) + w * 1024;
    float rl[16];
#pragma unroll
    for (int g = 0; g < 4; ++g) { const f32x4 t4 = *(const LAS f32x4*)(wsf + 8 * g + 4 * hi); rl[4 * g] = t4[0]; rl[4 * g + 1] = t4[1]; rl[4 * g + 2] = t4[2]; rl[4 * g + 3] = t4[3]; }
#pragma unroll
    for (int r = 0; r < 16; ++r) { const int orow = (r & 3) + 8 * (r >> 2) + 4 * hi; const float rc = rl[r];
        const float x0 = o0[r] * rc, x1 = o1[r] * rc;
        const float y0 = __builtin_bit_cast(float, __builtin_amdgcn_mov_dpp(__builtin_bit_cast(int, x0), 0xB1, 0xF, 0xF, true)), y1 = __builtin_bit_cast(float, __builtin_amdgcn_mov_dpp(__builtin_bit_cast(int, x1), 0xB1, 0xF, 0xF, true));
        const unsigned wv = (qq & 1) ? pk2(y1, x1) : pk2(x0, y0);
        stg[orow * 32 + ((qq & 1) ? 16 + (qq >> 1) : (qq >> 1))] = wv; }
    LDS_WAIT(); asm volatile("" ::: "memory");
    if (!ISB && br != 0) {
        bf16_t* OB = (bf16_t*)(ws + WS_OBR) + (size_t)(br - 1) * T * 512;
#pragma unroll
        for (int i = 0; i < 4; ++i) { const int row = i * 8 + (lane >> 3); const u32x4 v = *(const LAS u32x4*)(stg + row * 32 + ch * 4);
            const size_t orow = (size_t)((u.b * 8 + h) * dil + res) * (SEQ / dil) + (size_t)(mchunk0 + 32 * sub + row);
            __builtin_nontemporal_store(v, (u32x4*)(OB + orow * 64 + ch * 8)); }
        if (hi == 0) { float* LSE = (float*)(ws + WS_LSE) + (size_t)(br - 1) * T * 8; LSE[(size_t)((u.b * 8 + h) * dil + res) * (SEQ / dil) + mq] = mx + __builtin_amdgcn_logf(ls); }
    } else {
        bf16_t* MX = (bf16_t*)(ws + WS_MIXED); float* SSQ = (float*)(ws + (ISB ? WS_SSQB : WS_SSQA));
#pragma unroll
        for (int i = 0; i < 4; ++i) { const int row = i * 8 + (lane >> 3); const u32x4 v0 = *(const LAS u32x4*)(stg + row * 32 + ch * 4);
            const size_t grow = rowb + (size_t)(mchunk0 + 32 * sub + row);
            u32x4 wv = v0; float ss = 0.f;
            if (!ISB) {
                const float l0 = wsf[32 + row], lm = fmaxf(l0, fmaxf(l1[i], l2[i]));
                float w0 = __builtin_amdgcn_exp2f(l0 - lm), w1 = __builtin_amdgcn_exp2f(l1[i] - lm), w2 = __builtin_amdgcn_exp2f(l2[i] - lm);
                const float wi = __builtin_amdgcn_rcpf(w0 + w1 + w2); w0 *= wi; w1 *= wi; w2 *= wi;
#pragma unroll
                for (int e = 0; e < 4; ++e) { const float a = w0 * bflo(v0[e]) + w1 * bflo(v1[i][e]) + w2 * bflo(v2[i][e]), c = w0 * bfhi(v0[e]) + w1 * bfhi(v1[i][e]) + w2 * bfhi(v2[i][e]);
                    wv[e] = pk2(a, c); }
            }
#pragma unroll
            for (int e = 0; e < 4; ++e) { const float a = bflo(wv[e]), c = bfhi(wv[e]); ss += a * a + c * c; }
            ss += __shfl_xor(ss, 1); ss += __shfl_xor(ss, 2); ss += __shfl_xor(ss, 4);
            __builtin_nontemporal_store(wv, (u32x4*)(MX + grow * D + (ISB ? 512 : 0) + qhead * 64 + ch * 8));
            if (ch == 0) wsf[row] = ss; }
        LDS_WAIT(); asm volatile("" ::: "memory");
        if (lane < 32) SSQ[(size_t)qhead * T + rowb + (size_t)(mchunk0 + 32 * sub + lane)] = wsf[lane];
    }
}
template <int NK, bool ISB>
__device__ __forceinline__ void at_run(Frame F, int l, int ngroups, int pass) {
    F.ws = K_WS();
    u32x4 kr[NK * 8 / NTHREADS], vr[NK * 8 / NTHREADS], qr[4];
    const bool xm = F.G == 256;
    const int nunits = ngroups * 32;
    const int ubase = xm ? (((F.vcu >> 5) * (ngroups >> 3)) << 5) + (F.vcu & 31) : F.vcu, ustep = xm ? 32 : F.G;
    const int nr = xm ? (ngroups >> 3) : (nunits - F.vcu + F.G - 1) / F.G;
    if (nr <= 0) return;
    float sk0 = 0.f, sk1 = 0.f;
    if (ISB) { const float* sp = IN_F(8) + l * 8 + (F.wave >> 1); sk0 = sp[0] * LOG2E; sk1 = sp[4] * LOG2E; asm volatile("s_waitcnt vmcnt(0)" : "+v"(sk0), "+v"(sk1)); }
    { const AtU U = ISB ? at_decode_b(ubase) : at_decode_a(ubase, pass); at_load<NK, ISB>(F, U, kr, vr); at_load_q<ISB>(F, U, qr); at_wait_all<NK * 8 / NTHREADS>(kr, vr, qr); }
    for (int r = 0; r < nr; ++r) {
        const int u = ubase + r * ustep;
        const AtU U = ISB ? at_decode_b(u) : at_decode_a(u, pass);
        const bool has_next = r + 1 < nr;
        const AtU Un = has_next ? (ISB ? at_decode_b(u + ustep) : at_decode_a(u + ustep, pass)) : U;
        LDS_BARRIER();
        at_store<NK>(F, kr, vr);
        LDS_BARRIER();
        if (has_next) at_load<NK, ISB>(F, Un, kr, vr);
        at_compute<NK, ISB>(F, l, U, qr, kr, vr, has_next, Un, U.h ? sk1 : sk0);
    }
}
__device__ __forceinline__ void p2_attn(Frame F, int l, int pass) {
    asm volatile("" : "+s"(F.G), "+s"(F.vcu), "+s"(F.wave)); F.lane = lane_id(); asm volatile("" : "+v"(F.lane)); F.tid = F.wave * 64 + F.lane;
    if (pass == 0) { at_run<384, false>(F, l, BATCH * 8 * 2, 0); }
    else {
        at_run<384, false>(F, l, BATCH * 8, 1);
        at_run<192, true>(F, l, BATCH * 2 * 4, 1);
    }
    __syncthreads();
}
__device__ __forceinline__ void p5_router(Frame F, int l) {
    asm volatile("" : "+s"(F.G), "+s"(F.vcu), "+s"(F.wave)); F.lane = lane_id(); asm volatile("" : "+v"(F.lane)); F.tid = F.wave * 64 + F.lane;
    unsigned char* ws = K_WS();
    const bf16_t* XB1 = (const bf16_t*)(ws + WS_XB1); const bf16_t* WR = (const bf16_t*)(ws + WS_WR) + (size_t)l * 64 * D;
    const float* ssq1 = (const float*)(ws + WS_SSQ1); f32x4* tokinfo = (f32x4*)(ws + WS_TOKINFO); int* list = (int*)(ws + WS_LIST);
    gu32* gcnt = (gu32*)(ws + WS_CTL) + CW_GCNT + l * 128;
    LAS float* lg = (LAS float*)(F.lds + RING_OFF) + F.wave * (32 * 40);
    LAS int* lcnt = (LAS int*)(F.lds + CNT_OFF); LAS int* lbase = (LAS int*)(F.lds + LBASE_OFF);
    LAS int* ecl = (LAS int*)(F.lds + TOK_OFF); LAS int* ebl = ecl + 32;
    int* elist = (int*)(ws + WS_ELIST); gu32* gecnt = (gu32*)(ws + WS_CTL) + CW_ECNT + l * 32;
    const int r32 = F.lane & 31, hi = F.lane >> 5;
    constexpr int WRS_OFF = RING_OFF + 8 * 32 * 40 * 4, WRS_PITCH = 2048 + 16;
    static_assert(WRS_OFF + 36 * WRS_PITCH <= TOK_OFF, "router weight stage");
    __syncthreads();
    for (int idx = F.tid; idx < 36 * 128; idx += NTHREADS) { const int n = idx >> 7, c = idx & 127; *(LAS u32x4*)(F.lds + WRS_OFF + n * WRS_PITCH + c * 16) = *(const u32x4*)(WR + (size_t)n * D + c * 8); }
    __syncthreads();
    for (int ch = blockIdx.x; ch < T / 256; ch += F.G) {
        if (F.tid < 128) lcnt[F.tid] = 0;
        if (F.tid < 32) ecl[F.tid] = 0;
        __syncthreads();
        const int tok0 = ch * 256 + F.wave * 32;
        f32x16 c0 = {}, c1 = {};
        const bf16_t* ap = XB1 + (size_t)(tok0 + r32) * D + hi * 8;
        const LAS unsigned char* bp0 = F.lds + WRS_OFF + r32 * WRS_PITCH + hi * 16; const LAS unsigned char* bp1 = F.lds + WRS_OFF + (32 + (r32 & 3)) * WRS_PITCH + hi * 16;
#pragma unroll 8
        for (int s = 0; s < 64; ++s) {
            const bf16x8 a = *(const bf16x8*)(ap + s * 16), w0 = *(const LAS bf16x8*)(bp0 + s * 32), w1 = *(const LAS bf16x8*)(bp1 + s * 32);
            c0 = __builtin_amdgcn_mfma_f32_32x32x16_bf16(a, w0, c0, 0, 0, 0);
            c1 = __builtin_amdgcn_mfma_f32_32x32x16_bf16(a, w1, c1, 0, 0, 0);
        }
#pragma unroll
        for (int r = 0; r < 16; ++r) { const int tk = (r & 3) + 8 * (r >> 2) + 4 * hi; lg[tk * 40 + r32] = c0[r]; if (r32 < 4) lg[tk * 40 + 32 + r32] = c1[r]; }
        LDS_WAIT(); asm volatile("" ::: "memory");
        int bucket = 0, rank = 0, e_lo = 0, e_hi = 0, r_lo = 0, r_hi = 0; float t_rs = 0.f, t_glo = 0.f, t_ghi = 0.f; const int tok = tok0 + r32;
        if (hi == 0) {
            float sp[16];
#pragma unroll
            for (int p = 0; p < 16; ++p) sp[p] = ssq1[(size_t)p * T + tok];
            const float rs = __builtin_amdgcn_rsqf(((((sp[0] + sp[1]) + (sp[2] + sp[3])) + ((sp[4] + sp[5]) + (sp[6] + sp[7]))) + (((sp[8] + sp[9]) + (sp[10] + sp[11])) + ((sp[12] + sp[13]) + (sp[14] + sp[15])))) * (1.f / 1024.f) + EPS);
            const LAS float* lp = lg + r32 * 40;
            const float g0 = lp[32] * rs, g1 = lp[33] * rs, g2 = lp[34] * rs, g3 = lp[35] * rs;
            int gi = 0; float gm = g0; if (g1 > gm) { gm = g1; gi = 1; } if (g2 > gm) { gm = g2; gi = 2; } if (g3 > gm) { gm = g3; gi = 3; }
            const float gtop = 1.f / (__expf(g0 - gm) + __expf(g1 - gm) + __expf(g2 - gm) + __expf(g3 - gm));
            float e[8];
#pragma unroll
            for (int j = 0; j < 8; ++j) e[j] = lp[gi * 8 + j] * rs;
            int i1 = 0; float m1 = e[0];
#pragma unroll
            for (int j = 1; j < 8; ++j) if (e[j] > m1) { m1 = e[j]; i1 = j; }
            int i2 = (i1 == 0) ? 1 : 0; float m2 = -INFINITY;
#pragma unroll
            for (int j = 0; j < 8; ++j) if (j != i1 && e[j] > m2) { m2 = e[j]; i2 = j; }
            const float w2 = __expf(m2 - m1), gate1 = gtop / (1.f + w2), gate2 = gtop * w2 / (1.f + w2);
            const int lo = i1 < i2 ? i1 : i2, hix = i1 < i2 ? i2 : i1;
            const float glo = i1 < i2 ? gate1 : gate2, ghi = i1 < i2 ? gate2 : gate1;
            bucket = gi * 28 + (lo * (15 - lo)) / 2 + (hix - lo - 1);
            t_rs = rs; t_glo = glo; t_ghi = ghi; e_lo = gi * 8 + lo; e_hi = gi * 8 + hix;
            rank = __hip_atomic_fetch_add(&lcnt[bucket], 1, __ATOMIC_RELAXED, __HIP_MEMORY_SCOPE_WORKGROUP);
            r_lo = __hip_atomic_fetch_add(&ecl[e_lo], 1, __ATOMIC_RELAXED, __HIP_MEMORY_SCOPE_WORKGROUP); r_hi = __hip_atomic_fetch_add(&ecl[e_hi], 1, __ATOMIC_RELAXED, __HIP_MEMORY_SCOPE_WORKGROUP);
        }
        __syncthreads();
        if (F.tid < NBK) { const int c = lcnt[F.tid]; lbase[F.tid] = c ? (int)__hip_atomic_fetch_add(gcnt + F.tid, (unsigned)c, __ATOMIC_RELAXED, __HIP_MEMORY_SCOPE_AGENT) : 0; }
        if (F.tid >= 128 && F.tid < 160) { const int e = F.tid - 128, c = ecl[e]; ebl[e] = c ? (int)__hip_atomic_fetch_add(gecnt + e, (unsigned)c, __ATOMIC_RELAXED, __HIP_MEMORY_SCOPE_AGENT) : 0; }
        __syncthreads();
        if (hi == 0) { const int prow = lbase[bucket] + rank;
            list[(size_t)bucket * CAP + prow] = tok;
            tokinfo[tok] = (f32x4){t_rs, t_glo, t_ghi, 0.f}; ((unsigned*)(ws + WS_TOKROW))[tok] = ((unsigned)bucket << 16) | (unsigned)prow;
            elist[(size_t)e_lo * CAP + ebl[e_lo] + r_lo] = tok; elist[(size_t)e_hi * CAP + ebl[e_hi] + r_hi] = tok | (int)0x80000000; }
        __syncthreads();
    }
}

__device__ __forceinline__ int moe_prep(Frame F, int l, int coltiles) {
    asm volatile("" : "+s"(F.G), "+s"(F.vcu), "+s"(F.wave)); F.lane = lane_id(); asm volatile("" : "+v"(F.lane)); F.tid = F.wave * 64 + F.lane;
    LAS int* cntS = (LAS int*)(F.lds + CNT_OFF); LAS int* tst = (LAS int*)(F.lds + TST_OFF); LAS int* utab = (LAS int*)(F.lds + UNIT_OFF); LAS int* toktab = (LAS int*)(F.lds + TOK_OFF);
    unsigned char* ws = K_WS();
    const int* list = (const int*)(ws + WS_LIST);
    gu32* gcnt = (gu32*)(ws + WS_CTL) + CW_GCNT + l * 128;
    __syncthreads();
    if (F.tid < NBK) cntS[F.tid] = (int)__hip_atomic_load(gcnt + F.tid, __ATOMIC_RELAXED, __HIP_MEMORY_SCOPE_AGENT);
    __syncthreads();
    if (F.tid == 0) { int s = 0; for (int b = 0; b < NBK; ++b) { tst[b] = s; s += (cntS[b] + 255) >> 8; } tst[NBK] = s; }
    __syncthreads();
    const int ntile = tst[NBK], nunits = ntile * coltiles;
    int nmine = 0;
    for (int i = 0; i < MAXU; ++i) if (i * F.G + F.vcu < nunits) nmine = i + 1;
    if (F.tid < nmine) {
        const int L = F.tid * F.G + F.vcu, tg = L / coltiles, pn = L % coltiles;
        int bk = 0; for (int b = 0; b < NBK; ++b) if (tst[b] <= tg) bk = b;
        for (int b = 0; b < NBK; ++b) if (tst[b] <= tg && tg < tst[b + 1]) bk = b;
        int rows = cntS[bk] - (tg - tst[bk]) * 256; rows = rows > 256 ? 256 : rows;
        utab[F.tid * 4 + 0] = bk; utab[F.tid * 4 + 1] = tg; utab[F.tid * 4 + 2] = pn; utab[F.tid * 4 + 3] = rows;
    }
    __syncthreads();
    for (int idx = F.tid; idx < nmine * 256; idx += NTHREADS) {
        const int i = idx >> 8, r = idx & 255; const int bk = utab[i * 4 + 0], tg = utab[i * 4 + 1], rows = utab[i * 4 + 3];
        const int rr = r < rows ? r : 0;
        toktab[idx] = list[(size_t)bk * CAP + (tg - tst[bk]) * 256 + rr];
    }
    __syncthreads();
    return nmine;
}

__device__ __forceinline__ int moe_prep_e(Frame F, int l) {
    asm volatile("" : "+s"(F.G), "+s"(F.vcu), "+s"(F.wave)); F.lane = lane_id(); asm volatile("" : "+v"(F.lane)); F.tid = F.wave * 64 + F.lane;
    LAS int* cntS = (LAS int*)(F.lds + CNT_OFF); LAS int* tst = (LAS int*)(F.lds + TST_OFF); LAS int* utab = (LAS int*)(F.lds + UNIT_OFF); LAS int* toktab = (LAS int*)(F.lds + TOK_OFF);
    LAS int* etst = (LAS int*)(F.lds + LBASE_OFF); LAS int* ecnt = etst + 40;
    unsigned char* ws = K_WS();
    const int* elist = (const int*)(ws + WS_ELIST);
    gu32* gcnt = (gu32*)(ws + WS_CTL) + CW_GCNT + l * 128; gu32* gecnt = (gu32*)(ws + WS_CTL) + CW_ECNT + l * 32;
    __syncthreads();
    if (F.tid < NBK) cntS[F.tid] = (int)__hip_atomic_load(gcnt + F.tid, __ATOMIC_RELAXED, __HIP_MEMORY_SCOPE_AGENT);
    if (F.tid >= 128 && F.tid < 160) ecnt[F.tid - 128] = (int)__hip_atomic_load(gecnt + (F.tid - 128), __ATOMIC_RELAXED, __HIP_MEMORY_SCOPE_AGENT);
    __syncthreads();
    if (F.tid == 0) { int sp = 0; for (int b = 0; b < NBK; ++b) { tst[b] = sp; sp += (cntS[b] + 255) >> 8; } tst[NBK] = sp; }
    if (F.tid == 64) { int se = 0; for (int e = 0; e < NE; ++e) { etst[e] = se; se += (ecnt[e] + 255) >> 8; } etst[NE] = se; }
    __syncthreads();
    const int nunits = etst[NE] * 4;
    int nmine = 0;
    for (int i = 0; i < MAXU; ++i) if (i * F.G + F.vcu < nunits) nmine = i + 1;
    if (F.tid < nmine) {
        const int L = F.tid * F.G + F.vcu, tile = L >> 2, pn = L & 3;
        int e = 0; for (int b = 0; b < NE; ++b) if (etst[b] <= tile && tile < etst[b + 1]) e = b;
        int rows = ecnt[e] - (tile - etst[e]) * 256; rows = rows > 256 ? 256 : rows;
        utab[F.tid * 4 + 0] = e; utab[F.tid * 4 + 1] = tile - etst[e]; utab[F.tid * 4 + 2] = pn; utab[F.tid * 4 + 3] = rows;
    }
    __syncthreads();
    for (int idx = F.tid; idx < nmine * 256; idx += NTHREADS) {
        const int i = idx >> 8, r = idx & 255; const int e = utab[i * 4 + 0], tl = utab[i * 4 + 1], rows = utab[i * 4 + 3];
        toktab[idx] = elist[(size_t)e * CAP + tl * 256 + (r < rows ? r : 0)];
    }
    __syncthreads();
    return nmine;
}

__global__ void __launch_bounds__(NTHREADS, 2) mk_fwd(Args args) {
    Frame F;
    F.lds = LDSP(0);
    F.tid = 0; F.lane = 0; F.ws = nullptr; F.wave = __builtin_amdgcn_readfirstlane((int)threadIdx.x >> 6);
    F.G = gridDim.x; { const int bx = blockIdx.x; F.vcu = (F.G % 8 == 0) ? (bx % 8) * (F.G / 8) + bx / 8 : bx; }
    volatile LAS unsigned* MISC = (volatile LAS unsigned*)LDSP(MISC_OFF);
    if (threadIdx.x < 32) MISC[threadIdx.x] = 0u;
    __syncthreads();
    if (MK_N_LAUNCHES == 1) (void)xcd_barrier_post((unsigned*)(args.ws + WS_CTL) + CW_BAR, MISC + 8);
    const int lo = args.ph_lo, hi = args.ph_hi; (void)lo; (void)hi;
#if MK_N_LAUNCHES == 1
#define IN(k) true
#else
#define IN(k) (lo <= (k) && (k) < hi)
#endif
#define SEAM(k) do { if (IN(k) && IN((k) + 1) && (k) + 1 < NPHASE) { XcdBarrier bar_; bar_.bar = (unsigned*)(K_WS() + WS_CTL) + CW_BAR; bar_.st = (volatile LAS unsigned*)LDSP(MISC_OFF) + 8; xcd_barrier(bar_, F.wave); } } while (0)

    if (IN(0)) { p0_prologue(F); }
    SEAM(0);
    for (int l = 0; l < DEPTH; ++l) {
        const int pb = 1 + PPL * l;
        if (IN(pb)) {
            int G_ = F.G, bx_ = (int)blockIdx.x; asm volatile("" : "+s"(G_), "+s"(bx_));
            DenseSched S; S.a_off = WS_XN; S.b_off = WS_WIN + (size_t)l * PW * D * 2; S.pitchB = 2048; S.nN = PW / 256; S.c = bx_; S.G = G_;
            EpiQKV E{l};
            pg::gemm_phase<EpiQKV, DenseSched, false, false>(F.lds + RING_OFF, F.wave, S, E);
        }
        SEAM(pb);
        if (IN(pb + 1)) { p2_attn(F, l, 0); }
        SEAM(pb + 1);
        if (IN(pb + 2)) { p2_attn(F, l, 1); }
        SEAM(pb + 2);
        if (IN(pb + 3)) {
            int G_ = F.G, bx_ = (int)blockIdx.x; asm volatile("" : "+s"(G_), "+s"(bx_));
            DenseSched S; S.a_off = WS_MIXED; S.b_off = WS_WOUT + (size_t)l * D * D * 2; S.pitchB = 2048; S.nN = D / 256; S.c = bx_; S.G = G_;
            EpiRes E{l};
            pg::gemm_phase<EpiRes, DenseSched, false, false>(F.lds + RING_OFF, F.wave, S, E);
        }
        SEAM(pb + 3);
        if (IN(pb + 4)) { p5_router(F, l); }
        SEAM(pb + 4);
        if (IN(pb + 5)) {
            const int nmine = moe_prep_e(F, l);
            GuSched S; S.pitchB = 1024; S.l = l; S.nmine = nmine;
            EpiGU E{l};
            pg::gemm_phase<EpiGU, GuSched, true, true>(F.lds + RING_OFF, F.wave, S, E);
        }
        SEAM(pb + 5);
        if (IN(pb + 6)) {
            const int nmine = moe_prep(F, l, 4);
            DnSched S; S.pitchB = 512; S.l = l; S.nmine = nmine;
            EpiDown E{l};
            pg::gemm_phase<EpiDown, DnSched, true, true>(F.lds + RING_OFF, F.wave, S, E);
        }
        SEAM(pb + 6);
    }
#undef IN
#undef SEAM
}

extern "C" void kernel_launch(void* const* d_in, const int* in_sizes, int n_in, void* d_out, int out_size, void* d_ws, size_t ws_size, hipStream_t stream) {
    static int grid = 0;
    if (grid == 0) {
        if (n_in != 17 || out_size != T * D || ws_size < WS_END) { fprintf(stderr, "kernel_launch: unexpected shapes (n_in %d, out %d, ws %zu); nothing launched\n", n_in, out_size, ws_size); grid = -1; return; }
        int dev = 0, cus = 0;
        if (hipGetDevice(&dev) != hipSuccess || hipDeviceGetAttribute(&cus, hipDeviceAttributeMultiprocessorCount, dev) != hipSuccess) { grid = -1; return; }
        if (hipFuncSetAttribute((const void*)mk_fwd, hipFuncAttributeMaxDynamicSharedMemorySize, LDS_BYTES) != hipSuccess) { fprintf(stderr, "kernel_launch: hipFuncSetAttribute failed\n"); grid = -1; return; }
        int per_cu = 0;
        if (hipOccupancyMaxActiveBlocksPerMultiprocessor(&per_cu, (const void*)mk_fwd, NTHREADS, LDS_BYTES) != hipSuccess || per_cu < 1) fprintf(stderr, "kernel_launch: occupancy query says %d\n", per_cu);
        (void)hipGetLastError();
        grid = cus;
    }
    if (grid < 0) return;
    (void)in_sizes;
    if (hipMemsetAsync((char*)d_ws + WS_CTL, 0, CTL_ZERO_BYTES, stream) != hipSuccess) { fprintf(stderr, "kernel_launch: memset failed\n"); return; }
    Args a{};
    for (int i = 0; i < 17; ++i) a.in[i] = d_in[i];
    a.out = (float*)d_out; a.ws = (unsigned char*)d_ws;
    if (MK_N_LAUNCHES == 1) {
        a.ph_lo = 0; a.ph_hi = NPHASE;
        hipLaunchKernelGGL(mk_fwd, dim3(grid), dim3(NTHREADS), LDS_BYTES, stream, a);
    } else {
        for (int p = 0; p < NPHASE; ++p) { a.ph_lo = p; a.ph_hi = p + 1; hipLaunchKernelGGL(mk_fwd, dim3(grid), dim3(NTHREADS), LDS_BYTES, stream, a); }
    }
}
```

```cpp
#include <hip/hip_runtime.h>
#include <cstdio>
#include <cstdint>

#ifndef MK_N_LAUNCHES
#define MK_N_LAUNCHES 1
#endif

#define LAS __attribute__((address_space(3)))
#define GAS __attribute__((address_space(1)))
typedef unsigned short bf16_t;
typedef short bf16x8 __attribute__((ext_vector_type(8)));
typedef float f32x4 __attribute__((ext_vector_type(4)));
typedef float f32x16 __attribute__((ext_vector_type(16)));
typedef unsigned u32x4 __attribute__((ext_vector_type(4)));
typedef GAS unsigned gu32;

constexpr int BATCH = 8, SEQ = 8192, T = BATCH * SEQ, D = 1024, DEPTH = 2, HD = 64, PW = 2304;
constexpr int NE = 32, DE = 512, NBK = 112, CAP = 65536;
constexpr float EPS = 1e-6f, LOG2E = 1.4426950408889634f, QSCALE = 0.125f * 1.4426950408889634f;
constexpr int NWAVES = 8, NTHREADS = 512;
constexpr int PPL = 7;
constexpr int NPHASE = 1 + PPL * DEPTH;
constexpr float SW_GU = 128.f, SW_DN = 64.f, SA_A = 16.f;
constexpr int MAXU = 12;

constexpr size_t MiB = 1u << 20;
constexpr size_t WS_CTL = 0, CTL_ZERO_BYTES = 65536;
constexpr size_t WS_ROPE = 1 * MiB;
constexpr size_t WS_SSQ1 = 5 * MiB;
constexpr size_t WS_SSQ2 = 9 * MiB;
constexpr size_t WS_TOKINFO = 13 * MiB;
constexpr size_t WS_GAINS = 15 * MiB;
constexpr size_t WS_WR = 14 * MiB;
constexpr size_t WS_LIST = 16 * MiB;
constexpr size_t WS_WIN = 44 * MiB;
constexpr size_t WS_WOUT = 53 * MiB;
constexpr size_t WS_WGU8 = 57 * MiB;
constexpr size_t WS_WDN8 = 121 * MiB;
constexpr size_t WS_XF8 = 153 * MiB;
constexpr size_t WS_TOKROW = 225 * MiB;
constexpr size_t WS_ELIST = 217 * MiB;
constexpr size_t WS_QKV = 256 * MiB;
constexpr size_t WS_MIXED = 544 * MiB;
constexpr size_t WS_XB1 = 672 * MiB;
constexpr size_t WS_XN = 800 * MiB;
constexpr size_t WS_OBR = 672 * MiB;
constexpr size_t WS_LSE = 928 * MiB;
constexpr size_t WS_SSQA = 932 * MiB;
constexpr size_t WS_SSQB = 934 * MiB;
constexpr size_t WS_END = 936 * MiB;
constexpr int CW_ECNT = 320;
constexpr int CW_GCNT = 64;
constexpr int CW_BAR = 1024;

constexpr int RING_OFF = 0, RING_BYTES = 131072;
constexpr int TOK_OFF = 131072;
constexpr int UNIT_OFF = TOK_OFF + MAXU * 256 * 4;
constexpr int CNT_OFF = UNIT_OFF + 256;
constexpr int TST_OFF = CNT_OFF + 512;
constexpr int LBASE_OFF = TST_OFF + 512;
constexpr int MISC_OFF = LBASE_OFF + 512;
constexpr int EPST_OFF = 147456;
constexpr int LDS_BYTES = 163840;
static_assert(MISC_OFF + 128 <= EPST_OFF && EPST_OFF + 8 * 2048 <= LDS_BYTES, "LDS map");

extern __shared__ __attribute__((aligned(16))) unsigned char g_lds[];
#define LDSP(off) ((LAS unsigned char*)g_lds + (off))

__device__ __forceinline__ unsigned f2bf(float f) { unsigned u = __builtin_bit_cast(unsigned, f); return (u + 0x7fffu + ((u >> 16) & 1u)) >> 16; }
typedef float f32x2_t __attribute__((ext_vector_type(2))); typedef __bf16 bf16x2_t __attribute__((ext_vector_type(2)));
__device__ __forceinline__ unsigned pk2(float lo, float hi) { const f32x2_t v = {lo, hi}; const bf16x2_t b = __builtin_convertvector(v, bf16x2_t); return __builtin_bit_cast(unsigned, b); }
__device__ __forceinline__ float bflo(unsigned w) { return __builtin_bit_cast(float, w << 16); }
__device__ __forceinline__ float bfhi(unsigned w) { return __builtin_bit_cast(float, w & 0xffff0000u); }
__device__ __forceinline__ u32x4 pack8(const f32x4& a, const f32x4& b) { u32x4 w; w.x = pk2(a[0], a[1]); w.y = pk2(a[2], a[3]); w.z = pk2(b[0], b[1]); w.w = pk2(b[2], b[3]); return w; }
typedef int i32x4 __attribute__((ext_vector_type(4))); typedef int i32x8 __attribute__((ext_vector_type(8)));
__device__ __forceinline__ unsigned pk4_fp8(float a, float b, float c, float d) { int w = __builtin_amdgcn_cvt_pk_fp8_f32(a, b, 0, false); w = __builtin_amdgcn_cvt_pk_fp8_f32(c, d, w, true); return (unsigned)w; }
__device__ __forceinline__ float xor32_f(float x, bool upper  ) { float a = x, b = x; asm volatile("s_nop 1\n\tv_permlane32_swap_b32 %0, %1" : "+v"(a), "+v"(b)); return upper ? a : b; }
__device__ __forceinline__ float sum_xor32(float x) { float a = x, b = x; asm volatile("s_nop 1\n\tv_permlane32_swap_b32 %0, %1" : "+v"(a), "+v"(b)); return a + b; }
__device__ __forceinline__ float sum_xor16(float x) { float a = x, b = x; asm volatile("s_nop 1\n\tv_permlane16_swap_b32 %0, %1" : "+v"(a), "+v"(b)); return a + b; }
__device__ __forceinline__ float vmax3(float a, float b, float c) { float d; asm("v_max3_f32 %0, %1, %2, %3" : "=v"(d) : "v"(a), "v"(b), "v"(c)); return d; }
__device__ __forceinline__ float wave_sum(float v) {
#pragma unroll
    for (int o = 1; o < 64; o <<= 1) v += __shfl_xor(v, o);
    return v;
}
#define LDS_WAIT() asm volatile("s_waitcnt lgkmcnt(0)" ::: "memory")
#define LDS_BARRIER() do { asm volatile("s_waitcnt lgkmcnt(0)" ::: "memory"); __builtin_amdgcn_s_barrier(); asm volatile("" ::: "memory"); } while (0)
__device__ __forceinline__ int lane_id() { unsigned z = 0u; asm volatile("" : "+v"(z)); return (int)__builtin_amdgcn_mbcnt_hi(~0u, __builtin_amdgcn_mbcnt_lo(~0u, z)); }

#define XB_TMO      128
#define XB_XCNT(j)  (256  + 64 * (j))
#define XB_XSUB(j)  (1280 + 64 * (j))
#define XB_XGEN(j)  (2304 + 64 * (j))
#define XB_TOP      3328
#define XB_TOPGEN   3392
#define XCD_BAR_WORDS 3456
#define XB_SPIN_CAP (1u << 24)
__device__ __forceinline__ unsigned xb_ld(unsigned* p)              { return __hip_atomic_load(p, __ATOMIC_RELAXED, __HIP_MEMORY_SCOPE_AGENT); }
__device__ __forceinline__ unsigned xb_add(unsigned* p, unsigned v) { return __hip_atomic_fetch_add(p, v, __ATOMIC_RELAXED, __HIP_MEMORY_SCOPE_AGENT); }
__device__ __forceinline__ unsigned xb_xcc_id() { return (unsigned)__builtin_amdgcn_s_getreg((3 << 11) | 20) & 0xFu; }
#define XB_SPIN(cond, bar) do { unsigned _sp = 0; while (cond) { __builtin_amdgcn_s_sleep(1); \
    if ((++_sp & 255u) == 0u) { if (xb_ld(&(bar)[XB_TMO])) break; if (_sp > XB_SPIN_CAP) { atomicAdd(&(bar)[XB_TMO], 1u); break; } } } } while (0)
struct XcdBarrier { unsigned* bar; volatile LAS unsigned* st; };
__device__ __forceinline__ XcdBarrier xcd_barrier_post(unsigned* bar, volatile LAS unsigned* st) {
    XcdBarrier b; b.bar = bar; b.st = st;
    if (threadIdx.x == 0) (void)xb_add(&bar[XB_XCNT(xb_xcc_id())], 1u);
    return b;
}
__device__ __forceinline__ void xcd_barrier_complete(unsigned* bar, unsigned x, unsigned& nloc, unsigned& nx) {
    const unsigned G = gridDim.x * gridDim.y * gridDim.z;
    unsigned sum, cnt, mine, sp = 0u;
    for (;;) {
        sum = 0u; cnt = 0u; mine = 0u;
#pragma unroll
        for (unsigned j = 0; j < 16; ++j) { const unsigned c = xb_ld(&bar[XB_XCNT(j)]); sum += c; cnt += (c > 0u) ? 1u : 0u; mine = (j == x) ? c : mine; }
        if (sum == G) break;
        __builtin_amdgcn_s_sleep(1);
        if ((++sp & 255u) == 0u) { if (xb_ld(&bar[XB_TMO])) break; if (sp > XB_SPIN_CAP) { atomicAdd(&bar[XB_TMO], 1u); break; } }
    }
    nloc = mine > 0u ? mine : 1u; nx = cnt > 0u ? cnt : 1u;
}
__device__ __forceinline__ void xcd_barrier(const XcdBarrier& b, int wave) {
    asm volatile("s_waitcnt vmcnt(0)" ::: "memory");
    __syncthreads();
    if (wave == 0 && lane_id() == 0) {
        unsigned* bar = b.bar; const unsigned bx = xb_xcc_id();
        __builtin_amdgcn_s_waitcnt(0);
        unsigned nloc = b.st[0], nx = b.st[1];
        if (nloc == 0u) { xcd_barrier_complete(bar, bx, nloc, nx); b.st[0] = nloc; b.st[1] = nx; }
        const unsigned old = xb_add(&bar[XB_XSUB(bx)], 1u);
        const unsigned gen = old / nloc;
        if (old + 1u == (gen + 1u) * nloc) {
            __builtin_amdgcn_fence(__ATOMIC_RELEASE, "agent");
            asm volatile("s_waitcnt vmcnt(0)" ::: "memory");
            const unsigned og = xb_add(&bar[XB_TOP], 1u);
            const unsigned tg = og / nx;
            if (og + 1u == (tg + 1u) * nx) xb_add(&bar[XB_TOPGEN], 1u);
            else XB_SPIN(xb_ld(&bar[XB_TOPGEN]) == tg, bar);
            __builtin_amdgcn_fence(__ATOMIC_ACQUIRE, "agent");
            xb_add(&bar[XB_XGEN(bx)], 1u);
            asm volatile("s_waitcnt vmcnt(0)" ::: "memory");
        } else {
            XB_SPIN(xb_ld(&bar[XB_XGEN(bx)]) == gen, bar);
            __builtin_amdgcn_fence(__ATOMIC_ACQUIRE, "agent");
            asm volatile("s_waitcnt vmcnt(0)" ::: "memory");
        }
    }
    __syncthreads();
}

namespace pg {
constexpr int BM = 256, BK = 64, HALF = 128, HTB = HALF * BK * 2;
__device__ __forceinline__ int lds_byte(int r, int c) { const int st = (r >> 4) * 2 + (c >> 5), rr = r & 15, cc = c & 31, ob = rr * 64 + cc * 2; return st * 1024 + (ob ^ (((ob >> 9) & 1) << 5)); }
__device__ __forceinline__ void stage_rc(int b, int& R, int& C) { const int st = b / 1024, sb = b % 1024, swz = sb ^ (((sb >> 9) & 1) << 5); R = (st >> 1) * 16 + swz / 64; C = (st & 1) * 32 + (swz % 64) / 2; }
__device__ __forceinline__ int perm32(int rho) { const int n = rho >> 4, i = rho & 15; return 8 * (i >> 2) + 4 * n + (i & 3); }
struct Unit { const char* B0; int dB1; int arow, pn, slot; };
__device__ __forceinline__ void lane_rc(int tid, int i, int& R, int& C) { stage_rc(tid * 16 + i * 8192, R, C); }

template <class Epi, class Sched, bool GATHER, bool FP8>
__device__ __forceinline__ void gemm_phase(LAS unsigned char* lds, int wid, const Sched& S, const Epi& E) {
    asm volatile("" : "+s"(wid));
    int lane = lane_id(); asm volatile("" : "+v"(lane));
    const int tid = wid * 64 + lane, wr = wid >> 2, wc = wid & 3, fr = lane & 15, fq = lane >> 4;
    constexpr int NKT = FP8 ? 8 : 16, KSPLIT = NKT / 2;
    constexpr unsigned PITCHA = FP8 ? 1024u : 2048u;
    unsigned voffA[2], voffB[2];
#pragma unroll
    for (int i = 0; i < 2; ++i) { int R, C; stage_rc(tid * 16 + i * 8192, R, C); const int Rb = (R & ~31) + perm32(R & 31); voffA[i] = (unsigned)(R * PITCHA + C * 2); voffB[i] = (unsigned)(Rb * S.pitchB + C * 2); }
    const unsigned hstepB = 128u * (unsigned)S.pitchB;
    constexpr unsigned hstepA = 128u * PITCHA;
    const unsigned ldsw = (unsigned)wid * 1024u;
    const int aoff = lds_byte(wr * 64 + fr, fq * 8), boff = lds_byte(wc * 32 + fr, fq * 8);
#define PG_SA(b, h) (((b) * 2 + (h)) * HTB)
#define PG_SB(b, h) ((4 + (b) * 2 + (h)) * HTB)
#define PG_STAGE_A(bufoff, ptr, half) do { _Pragma("unroll") for (int _i = 0; _i < 2; ++_i) { \
        const char* _src = GATHER ? ((ptr) + ga[half][_i]) : ((ptr) + (half) * hstepA + voffA[_i]); \
        __builtin_amdgcn_global_load_lds((const unsigned*)_src, (LAS unsigned*)(lds + (bufoff) + ldsw + _i * 8192), 16, 0, 0); } } while (0)
#define PG_STAGE_B(bufoff, ptr, half) do { _Pragma("unroll") for (int _i = 0; _i < 2; ++_i) \
        __builtin_amdgcn_global_load_lds((const unsigned*)((ptr) + (half) * hstepB + voffB[_i]), (LAS unsigned*)(lds + (bufoff) + ldsw + _i * 8192), 16, 0, 0); } while (0)
#define PG_LDA(dst, b, h) do { _Pragma("unroll") for (int m = 0; m < 4; ++m) _Pragma("unroll") for (int k = 0; k < 2; ++k) dst[m][k] = *(const LAS bf16x8*)(lds + PG_SA(b, h) + aoff + m * 2048 + k * 1024); } while (0)
#define PG_LDB(dst, b, h) do { _Pragma("unroll") for (int n = 0; n < 2; ++n) _Pragma("unroll") for (int k = 0; k < 2; ++k) dst[n][k] = *(const LAS bf16x8*)(lds + PG_SB(b, h) + boff + n * 2048 + k * 1024); } while (0)
#define PG_MMA(ai, bj, At, Bt) do { __builtin_amdgcn_s_setprio(1); _Pragma("unroll") for (int m = 0; m < 4; ++m) _Pragma("unroll") for (int n = 0; n < 2; ++n) _Pragma("unroll") for (int k = 0; k < 2; ++k) \
        acc[ai][bj][m][n] = __builtin_amdgcn_mfma_f32_16x16x32_bf16(Bt[n][k], At[m][k], acc[ai][bj][m][n], 0, 0, 0); __builtin_amdgcn_s_setprio(0); } while (0)
#define PG_LDA8(dst, b, h) do { _Pragma("unroll") for (int m = 0; m < 4; ++m) { const i32x4 lo_ = *(const LAS i32x4*)(lds + PG_SA(b, h) + aoff + m * 2048), hi_ = *(const LAS i32x4*)(lds + PG_SA(b, h) + aoff + m * 2048 + 1024); dst[m] = __builtin_shufflevector(lo_, hi_, 0, 1, 2, 3, 4, 5, 6, 7); } } while (0)
#define PG_LDB8(dst, b, h) do { _Pragma("unroll") for (int n = 0; n < 2; ++n) { const i32x4 lo_ = *(const LAS i32x4*)(lds + PG_SB(b, h) + boff + n * 2048), hi_ = *(const LAS i32x4*)(lds + PG_SB(b, h) + boff + n * 2048 + 1024); dst[n] = __builtin_shufflevector(lo_, hi_, 0, 1, 2, 3, 4, 5, 6, 7); } } while (0)
#define PG_MMA8(ai, bj, At, Bt) do { __builtin_amdgcn_s_setprio(1); _Pragma("unroll") for (int m = 0; m < 4; ++m) _Pragma("unroll") for (int n = 0; n < 2; ++n) \
        acc[ai][bj][m][n] = __builtin_amdgcn_mfma_scale_f32_16x16x128_f8f6f4(Bt[n], At[m], acc[ai][bj][m][n], 0, 0, 0, 0x7f7f7f7f, 0, 0x7f7f7f7f); __builtin_amdgcn_s_setprio(0); } while (0)
#define PG_WAIT_V(n) asm volatile("s_waitcnt vmcnt(" #n ")" ::: "memory")
#define PG_WAIT_L(n) asm volatile("s_waitcnt lgkmcnt(" #n ")" ::: "memory")
#define PG_WAIT_VS(after_epi) do { if constexpr (Epi::NSTORE == 16) { if (after_epi) asm volatile("s_waitcnt vmcnt(24)" ::: "memory"); else asm volatile("s_waitcnt vmcnt(8)" ::: "memory"); } else asm volatile("s_waitcnt vmcnt(8)" ::: "memory"); } while (0)
#define PG_BAR __builtin_amdgcn_s_barrier()
#define PG_SCHED __builtin_amdgcn_sched_barrier(0)
    Unit cur, nxt; int ui = 0;
    if (!S.next(0, cur)) return;
    f32x4 acc[2][2][4][2];
#pragma unroll
    for (int a = 0; a < 2; ++a)
#pragma unroll
        for (int b = 0; b < 2; ++b)
#pragma unroll
            for (int m = 0; m < 4; ++m)
#pragma unroll
                for (int n = 0; n < 2; ++n) acc[a][b][m][n] = (f32x4){0.f, 0.f, 0.f, 0.f};
    bf16x8 At[4][2], B0[2][2], B1[2][2]; i32x8 At8[4], B08[2], B18[2];
    unsigned ga[2][2] = {{0u, 0u}, {0u, 0u}};
    if constexpr (GATHER) S.aoffs(cur, tid, ga);
    if constexpr (Epi::HAS_MID) E.unit_begin(cur, 0, tid);
    const char* cA = S.abase() + (GATHER ? (size_t)0 : (size_t)cur.arow * (256u * PITCHA));
    PG_STAGE_B(PG_SB(0, 0), cur.B0, 0); PG_STAGE_B(PG_SB(0, 1), cur.B0, 1); PG_STAGE_A(PG_SA(0, 0), cA, 0); PG_STAGE_A(PG_SA(0, 1), cA, 1);
    if (wr == 1) PG_BAR;
    PG_WAIT_V(2); PG_BAR;
    PG_STAGE_B(PG_SB(1, 0), cur.B0 + 128, 0); PG_STAGE_A(PG_SA(1, 0), cA + 128, 0); PG_STAGE_B(PG_SB(1, 1), cur.B0 + 128, 1);
    PG_WAIT_V(6); PG_BAR;
    for (;;) {
        const bool has_next = S.next(ui + 1, nxt);
        if (!has_next) nxt = cur;
        const char* nA = S.abase() + (GATHER ? (size_t)0 : (size_t)nxt.arow * (256u * PITCHA));
#pragma unroll 1
        for (int t = 0; t < NKT; t += 2) {
            const bool last = (t == NKT - 2);
            if constexpr (Epi::HAS_MID) { if (t == KSPLIT) { E.mid(acc, ui & 1, wr, lane_id() & 15); PG_SCHED; } }
            const char* a1 = cA + (t + 1) * 128;
            const char* a2 = last ? nA : cA + (t + 2) * 128; const char* a3 = a2 + 128;
            const char* b2 = last ? nxt.B0 : (cur.B0 + (t + 2 < KSPLIT ? 0 : cur.dB1) + ((t + 2) & (KSPLIT - 1)) * 128);
            const char* b3 = b2 + 128;
            if constexpr (!FP8) {
            const bool aft = (t == 0) && (ui > 0);
            PG_LDB(B0, 0, 0); PG_LDB(B1, 0, 1); PG_SCHED; PG_LDA(At, 0, 0); PG_STAGE_A(PG_SA(1, 1), a1, 1);
            PG_WAIT_VS(aft); PG_WAIT_L(0); PG_BAR; PG_MMA(0, 0, At, B0); PG_MMA(0, 1, At, B1); PG_BAR; PG_SCHED;
            if constexpr (GATHER) { if (last) { S.aoffs(nxt, wid * 64 + lane_id(), ga); PG_SCHED; } }
            PG_LDA(At, 0, 1); PG_STAGE_B(PG_SB(0, 0), b2, 0); PG_STAGE_B(PG_SB(0, 1), b2, 1); PG_STAGE_A(PG_SA(0, 0), a2, 0);
            PG_WAIT_VS(aft); PG_WAIT_L(0); PG_BAR; PG_MMA(1, 0, At, B0); PG_MMA(1, 1, At, B1); PG_BAR; PG_SCHED;
            PG_LDB(B0, 1, 0); PG_LDB(B1, 1, 1); PG_SCHED; PG_LDA(At, 1, 0); PG_STAGE_A(PG_SA(0, 1), a2, 1);
            PG_WAIT_VS(aft); PG_WAIT_L(0); PG_BAR; PG_MMA(0, 0, At, B0); PG_MMA(0, 1, At, B1); PG_BAR; PG_SCHED;
            PG_LDA(At, 1, 1); PG_STAGE_B(PG_SB(1, 0), b3, 0); PG_STAGE_B(PG_SB(1, 1), b3, 1); PG_STAGE_A(PG_SA(1, 0), a3, 0);
            PG_WAIT_V(8); PG_WAIT_L(0); PG_BAR; PG_MMA(1, 0, At, B0); PG_MMA(1, 1, At, B1); PG_BAR; PG_SCHED;
            } else {
            PG_LDB8(B08, 0, 0); PG_LDB8(B18, 0, 1); PG_SCHED; PG_LDA8(At8, 0, 0); PG_STAGE_A(PG_SA(1, 1), a1, 1);
            PG_WAIT_V(8); PG_WAIT_L(0); PG_BAR; PG_MMA8(0, 0, At8, B08); PG_MMA8(0, 1, At8, B18); PG_BAR; PG_SCHED;
            if constexpr (GATHER) { if (last) { S.aoffs(nxt, wid * 64 + lane_id(), ga); PG_SCHED; } }
            PG_LDA8(At8, 0, 1); PG_STAGE_B(PG_SB(0, 0), b2, 0); PG_STAGE_B(PG_SB(0, 1), b2, 1); PG_STAGE_A(PG_SA(0, 0), a2, 0);
            PG_WAIT_V(8); PG_WAIT_L(0); PG_BAR; PG_MMA8(1, 0, At8, B08); PG_MMA8(1, 1, At8, B18); PG_BAR; PG_SCHED;
            PG_LDB8(B08, 1, 0); PG_LDB8(B18, 1, 1); PG_SCHED; PG_LDA8(At8, 1, 0); PG_STAGE_A(PG_SA(0, 1), a2, 1);
            PG_WAIT_V(8); PG_WAIT_L(0); PG_BAR; PG_MMA8(0, 0, At8, B08); PG_MMA8(0, 1, At8, B18); PG_BAR; PG_SCHED;
            PG_LDA8(At8, 1, 1); PG_STAGE_B(PG_SB(1, 0), b3, 0); PG_STAGE_B(PG_SB(1, 1), b3, 1); PG_STAGE_A(PG_SA(1, 0), a3, 0);
            PG_WAIT_V(8); PG_WAIT_L(0); PG_BAR; PG_MMA8(1, 0, At8, B08); PG_MMA8(1, 1, At8, B18); PG_BAR; PG_SCHED;
            }
        }
        if (wr == 0) PG_BAR;
        { const int ln_ = lane_id(); E(acc, cur, ui, wr, wc, ln_ & 15, ln_ >> 4); }
        if (!has_next) break;
#pragma unroll
        for (int a = 0; a < 2; ++a)
#pragma unroll
            for (int b = 0; b < 2; ++b)
#pragma unroll
                for (int m = 0; m < 4; ++m)
#pragma unroll
                    for (int n = 0; n < 2; ++n) acc[a][b][m][n] = (f32x4){0.f, 0.f, 0.f, 0.f};
        cur = nxt; cA = nA; ++ui;
        if constexpr (Epi::HAS_MID) E.unit_begin(cur, ui & 1, wid * 64 + lane_id());
        if (wr == 1) PG_BAR;
    }
    PG_WAIT_V(0);
    PG_BAR;
#undef PG_SA
#undef PG_SB
#undef PG_STAGE_A
#undef PG_STAGE_B
#undef PG_LDA
#undef PG_LDB
#undef PG_MMA
#undef PG_LDA8
#undef PG_LDB8
#undef PG_MMA8
#undef PG_WAIT_V
#undef PG_WAIT_L
#undef PG_BAR
#undef PG_SCHED
}
}

struct Args { const void* in[17]; float* out; unsigned char* ws; int ph_lo, ph_hi; };
__device__ __forceinline__ const void* karg_ld(int byte_off) {
    auto kp = __builtin_amdgcn_kernarg_segment_ptr(); unsigned long long v;
    asm volatile("s_load_dwordx2 %0, %1, %2\n\ts_waitcnt lgkmcnt(0)" : "=s"(v) : "s"(kp), "s"(byte_off) : "memory");
    return (const void*)(GAS const void*)v;
}
#define IN_F(k) ((const float*)karg_ld((k) * 8))
#define IN_I(k) ((const int*)karg_ld((k) * 8))
#define K_OUT() ((float*)karg_ld(17 * 8))
#define K_WS() ((unsigned char*)karg_ld(18 * 8))
struct Frame {
    LAS unsigned char* lds;
    int tid, lane, wave, G, vcu;
    unsigned char* ws;
};

struct DenseSched {
    size_t a_off, b_off; int pitchB, nN, c, G;
    __device__ __forceinline__ const char* abase() const { return (const char*)K_WS() + a_off; }
    __device__ __forceinline__ bool next(int i, pg::Unit& u) const {
        const int nM = T / 256, nwg = nM * nN;
        const long L = (long)i * G + c; if (L >= nwg) return false;
        int wgid = (int)L; { const int q = nwg / 8, r = nwg % 8, xcd = wgid % 8, off = wgid / 8; wgid = (xcd < r ? xcd * (q + 1) : r * (q + 1) + (xcd - r) * q) + off; }
        const int nig = 8 * nN, gid = wgid / nig, fm = gid * 8, gsz = (nM - fm) < 8 ? (nM - fm) : 8;
        u.arow = fm + ((wgid % nig) % gsz); u.pn = (wgid % nig) / gsz; u.slot = 0;
        u.B0 = (const char*)K_WS() + b_off + (size_t)u.pn * 256 * 2048; u.dB1 = 1024; return true;
    }
};
__device__ __forceinline__ void bucket_experts(int bk, int& e_lo, int& e_hi) {
    const int g = bk / 28; int p = bk % 28; int lo = 0;
#pragma unroll
    for (int k = 0; k < 7; ++k) { const int len = 7 - k; if (lo == k && p >= len) { p -= len; lo = k + 1; } }
    e_lo = g * 8 + lo; e_hi = g * 8 + lo + 1 + p;
}
__device__ __forceinline__ int utab_get(int i, int f) { return __builtin_amdgcn_readfirstlane(((volatile LAS int*)LDSP(UNIT_OFF))[i * 4 + f]); }
struct GuSched {
    int pitchB, l, nmine;
    __device__ __forceinline__ const char* abase() const { return (const char*)K_WS() + WS_XF8; }
    __device__ __forceinline__ bool next(int i, pg::Unit& u) const {
        if (i >= nmine) return false;
        const int e = utab_get(i, 0), pn = utab_get(i, 2);
        u.slot = i; u.pn = pn; u.arow = 0;
        u.B0 = (const char*)K_WS() + WS_WGU8 + (((size_t)l * NE + e) * 1024 + (size_t)pn * 256) * 1024; u.dB1 = 512; return true;
    }
    __device__ __forceinline__ void aoffs(const pg::Unit& u, int tid, unsigned (&o)[2][2]) const {
        volatile LAS int* vt = (volatile LAS int*)LDSP(TOK_OFF);
#pragma unroll
        for (int i = 0; i < 2; ++i) { int R, C; pg::lane_rc(tid, i, R, C);
#pragma unroll
            for (int ai = 0; ai < 2; ++ai) { const int tok = vt[u.slot * 256 + ai * 128 + R] & 0x7fffffff; o[ai][i] = (unsigned)(tok * 1024 + C * 2); } }
    }
};
struct DnSched {
    int pitchB, l, nmine;
    __device__ __forceinline__ const char* abase() const { return (const char*)K_WS() + WS_QKV; }
    __device__ __forceinline__ bool next(int i, pg::Unit& u) const {
        if (i >= nmine) return false;
        const int bk = utab_get(i, 0), tg = utab_get(i, 1), pn = utab_get(i, 2);
        int elo, ehi; bucket_experts(bk, elo, ehi);
        u.slot = i; u.pn = pn; u.arow = tg;
        u.B0 = (const char*)K_WS() + WS_WDN8 + (((size_t)l * NE + elo) * 1024 + (size_t)pn * 256) * 512; u.dB1 = (ehi - elo) * 1024 * 512; return true;
    }
    __device__ __forceinline__ void aoffs(const pg::Unit& u, int tid, unsigned (&o)[2][2]) const {
#pragma unroll
        for (int i = 0; i < 2; ++i) { int R, C; pg::lane_rc(tid, i, R, C);
#pragma unroll
            for (int ai = 0; ai < 2; ++ai) o[ai][i] = (unsigned)((u.arow * 256 + ai * 128 + R) * 1024 + C * 2); }
    }
};

struct EpiQKV {
    static constexpr int NSTORE = 0;
    static constexpr bool HAS_MID = false; int l;
    __device__ __forceinline__ void operator()(const f32x4 (&acc)[2][2][4][2], const pg::Unit& u, int ui, int wr, int wc, int fr, int fq) const {
        asm volatile("" : "+v"(fr), "+v"(fq));
        unsigned char* ws = K_WS();
        bf16_t* qkv = (bf16_t*)(ws + WS_QKV); const float* ssq = (const float*)(ws + WS_SSQ2); const unsigned* rope = (const unsigned*)(ws + WS_ROPE);
        const int pm = u.arow, pn = u.pn, hh = pn * 4 + wc, lane = fq * 16 + fr, wid = wr * 4 + wc;
        const bool isq = (hh < 8) || (hh >= 24 && hh < 32);
        const bool isk = (hh >= 8 && hh < 16) || (hh == 32) || (hh == 33);
        const bool normed = isq || isk;
        const int gsel = hh < 8 ? 0 : (hh < 16 ? 1 : (hh < 32 ? 2 : 3));
        const float* gp = (const float*)(ws + WS_GAINS) + (l * 4 + gsel) * 64;
        const float qs = isq ? QSCALE : 1.f;
        const int fa = fq >> 1, fb = fq & 1;
        f32x4 g[2][2];
#pragma unroll
        for (int bj = 0; bj < 2; ++bj)
#pragma unroll
            for (int n = 0; n < 2; ++n) g[bj][n] = *(const f32x4*)(gp + 32 * bj + 16 * fa + 8 * n + 4 * fb) * qs;
        f32x4 sp4[2][4];
#pragma unroll
        for (int ai = 0; ai < 2; ++ai) { const f32x4* sp = (const f32x4*)(ssq + (size_t)(pm * 256 + ai * 128 + wr * 64 + lane) * 16); sp4[ai][0] = sp[0]; sp4[ai][1] = sp[1]; sp4[ai][2] = sp[2]; sp4[ai][3] = sp[3]; }
        u32x4 rp0[4], rp1[4];
        if (normed) {
#pragma unroll
            for (int m = 0; m < 4; ++m) rp0[m] = *(const u32x4*)(rope + (size_t)(fa ? T : pm * 256 + wr * 64 + m * 16 + fr) * 8 + 4 * fb);
        }
        float rxl[2];
#pragma unroll
        for (int ai = 0; ai < 2; ++ai) { const f32x4 s4 = (sp4[ai][0] + sp4[ai][1]) + (sp4[ai][2] + sp4[ai][3]); rxl[ai] = __builtin_amdgcn_rsqf(((s4[0] + s4[1]) + (s4[2] + s4[3])) * (1.f / 1024.f) + EPS); }
#pragma unroll
        for (int ai = 0; ai < 2; ++ai) {
            if (ai == 1 && normed) {
#pragma unroll
                for (int m = 0; m < 4; ++m) rp1[m] = *(const u32x4*)(rope + (size_t)(fa ? T : pm * 256 + 128 + wr * 64 + m * 16 + fr) * 8 + 4 * fb);
            }
            u32x4 (&rp)[4] = ai ? rp1 : rp0;
            float rx[4];
#pragma unroll
            for (int m = 0; m < 4; ++m) rx[m] = __shfl(rxl[ai], m * 16 + fr);
#pragma unroll
            for (int m = 0; m < 4; ++m) {
                const int row = pm * 256 + ai * 128 + wr * 64 + m * 16 + fr;
                const f32x4 a00 = acc[ai][0][m][0], a01 = acc[ai][0][m][1], a10 = acc[ai][1][m][0], a11 = acc[ai][1][m][1];
                f32x4 v00, v01, v10, v11;
                if (normed) {
                    const f32x4 sq = (a00 * a00 + a01 * a01) + (a10 * a10 + a11 * a11);
                    float ss = (sq[0] + sq[1]) + (sq[2] + sq[3]);
                    ss = sum_xor32(sum_xor16(ss));
                    const float sc = rx[m] * __builtin_amdgcn_rsqf(rx[m] * rx[m] * ss * (1.f / 64.f) + EPS);
                    v00 = a00 * (g[0][0] * sc); v01 = a01 * (g[0][1] * sc); v10 = a10 * (g[1][0] * sc); v11 = a11 * (g[1][1] * sc);
#pragma unroll
                    for (int i = 0; i < 4; ++i) { const float c = bflo(rp[m][i]), sn = bfhi(rp[m][i]), x1 = v00[i], x2 = v01[i]; v00[i] = x1 * c - x2 * sn; v01[i] = x2 * c + x1 * sn; }
                } else { v00 = a00 * rx[m]; v01 = a01 * rx[m]; v10 = a10 * rx[m]; v11 = a11 * rx[m]; }
                { LAS unsigned char* stg = LDSP(EPST_OFF) + wid * 2048;
                  { typedef unsigned u32x2 __attribute__((ext_vector_type(2))); LAS unsigned char* sr = stg + fr * 128 + 8 * fb; const int sx = fr & 7;
                    *(LAS u32x2*)(sr + (((2 * fa) ^ sx) << 4)) = (u32x2){pk2(v00[0], v00[1]), pk2(v00[2], v00[3])}; *(LAS u32x2*)(sr + (((2 * fa + 1) ^ sx) << 4)) = (u32x2){pk2(v01[0], v01[1]), pk2(v01[2], v01[3])};
                    *(LAS u32x2*)(sr + (((4 + 2 * fa) ^ sx) << 4)) = (u32x2){pk2(v10[0], v10[1]), pk2(v10[2], v10[3])}; *(LAS u32x2*)(sr + (((5 + 2 * fa) ^ sx) << 4)) = (u32x2){pk2(v11[0], v11[1]), pk2(v11[2], v11[3])}; }
                  LDS_WAIT(); asm volatile("" ::: "memory");
                  const int row0 = pm * 256 + ai * 128 + wr * 64 + m * 16;
                  bf16_t* gp0 = qkv + (((size_t)(row0 >> 13) * 36 + hh) * SEQ + (row0 & (SEQ - 1))) * 64;
#pragma unroll
                  for (int k = 0; k < 2; ++k) { const int r16 = (lane >> 3) + 8 * k, ch = lane & 7; const u32x4 w = *(const LAS u32x4*)(stg + r16 * 128 + ((ch ^ (r16 & 7)) << 4));
                      *(u32x4*)(gp0 + r16 * 64 + ch * 8) = w; }
                  LDS_WAIT(); asm volatile("" ::: "memory"); }
            }
            asm volatile("" ::: "memory");
        }
    }
};
constexpr int NRM_OFF = TOK_OFF;
struct EpiRes {
    static constexpr int NSTORE = 0;
    static constexpr bool HAS_MID = true; int l;
    __device__ __forceinline__ void unit_begin(const pg::Unit& u, int par, int tid) const {
        unsigned char* ws = K_WS();
        const int row = u.arow * 256 + (tid >> 1), side = tid & 1;
        const float* sp = (const float*)(ws + (side ? WS_SSQB : WS_SSQA)) + row;
        float sh[8];
#pragma unroll
        for (int h = 0; h < 8; ++h) sh[h] = sp[(size_t)h * T];
        const float r = __builtin_amdgcn_rsqf((((sh[0] + sh[1]) + (sh[2] + sh[3])) + ((sh[4] + sh[5]) + (sh[6] + sh[7]))) * (1.f / 512.f) + EPS), o = __shfl_xor(r, 1);
        LAS float* tab = (LAS float*)LDSP(NRM_OFF) + par * 512;
        if (side == 0) tab[tid >> 1] = r * __builtin_amdgcn_rcpf(o); else tab[256 + (tid >> 1)] = r;
    }
    __device__ __forceinline__ void mid(f32x4 (&acc)[2][2][4][2], int par, int wr, int fr) const {
        const LAS float* tab = (const LAS float*)LDSP(NRM_OFF) + par * 512;
#pragma unroll
        for (int ai = 0; ai < 2; ++ai)
#pragma unroll
            for (int m = 0; m < 4; ++m) { const float sc = tab[ai * 128 + wr * 64 + m * 16 + fr];
#pragma unroll
                for (int bj = 0; bj < 2; ++bj)
#pragma unroll
                    for (int n = 0; n < 2; ++n) acc[ai][bj][m][n] *= sc; }
    }
    __device__ __forceinline__ void operator()(const f32x4 (&acc)[2][2][4][2], const pg::Unit& u, int ui, int wr, int wc, int fr, int fq) const {
        asm volatile("" : "+v"(fr), "+v"(fq));
        unsigned char* ws = K_WS(); const bf16_t* xnb = (const bf16_t*)(ws + WS_XN);
        bf16_t* xb = (bf16_t*)(ws + WS_XB1); float* ssq = (float*)(ws + WS_SSQ1); unsigned char* xf8 = ws + WS_XF8;
        const LAS float* rbt = (const LAS float*)LDSP(NRM_OFF) + (ui & 1) * 512 + 256;
        const int pm = u.arow, pn = u.pn;
#pragma unroll
        for (int ai = 0; ai < 2; ++ai) {
            f32x4 xv[4][2][2];
#pragma unroll
            for (int m = 0; m < 4; ++m)
#pragma unroll
                for (int bj = 0; bj < 2; ++bj) { const size_t off = (size_t)(pm * 256 + ai * 128 + wr * 64 + m * 16 + fr) * D + pn * 256 + 128 * bj + 32 * wc + 8 * fq;
                    { const u32x4 w = *(const u32x4*)(xnb + off); xv[m][bj][0] = (f32x4){bflo(w.x), bfhi(w.x), bflo(w.y), bfhi(w.y)}; xv[m][bj][1] = (f32x4){bflo(w.z), bfhi(w.z), bflo(w.w), bfhi(w.w)}; } }
            float keep = 0.f;
#pragma unroll
            for (int m = 0; m < 4; ++m) {
                const int row = pm * 256 + ai * 128 + wr * 64 + m * 16 + fr; float ss = 0.f;
                const float rb = rbt[ai * 128 + wr * 64 + m * 16 + fr];
#pragma unroll
                for (int bj = 0; bj < 2; ++bj) {
                    const size_t off = (size_t)row * D + pn * 256 + 128 * bj + 32 * wc + 8 * fq;
                    const f32x4 o0 = xv[m][bj][0] + acc[ai][bj][m][0] * rb, o1 = xv[m][bj][1] + acc[ai][bj][m][1] * rb;
                    *(u32x4*)(xb + off) = pack8(o0, o1);
                    { typedef unsigned u32x2 __attribute__((ext_vector_type(2))); u32x2 w8; w8.x = pk4_fp8(o0[0], o0[1], o0[2], o0[3]); w8.y = pk4_fp8(o1[0], o1[1], o1[2], o1[3]); *(u32x2*)(xf8 + off) = w8; }
                    { const f32x4 q4 = o0 * o0 + o1 * o1; ss += (q4[0] + q4[1]) + (q4[2] + q4[3]); }
                }
                ss += __shfl_xor(ss, 16); ss += __shfl_xor(ss, 32);
                keep = (fq == m) ? ss : keep;
            }
            ssq[(size_t)(pn * 4 + wc) * T + pm * 256 + ai * 128 + wr * 64 + fq * 16 + fr] = keep;
            asm volatile("" ::: "memory");
        }
    }
};
struct EpiGU {
    static constexpr int NSTORE = 0;
    static constexpr bool HAS_MID = false; int l;
    __device__ __forceinline__ void operator()(const f32x4 (&acc)[2][2][4][2], const pg::Unit& u, int ui, int wr, int wc, int fr, int fq) const {
        asm volatile("" : "+v"(fr), "+v"(fq));
        unsigned char* ws = K_WS();
        unsigned char* abuf = ws + WS_QKV; const f32x4* tokinfo = (const f32x4*)(ws + WS_TOKINFO);
        volatile LAS int* toktab = (volatile LAS int*)LDSP(TOK_OFF); volatile LAS int* tst = (volatile LAS int*)LDSP(TST_OFF);
        const int slot = u.slot, pn = u.pn, rows = utab_get(slot, 3);
#pragma unroll
        for (int ai = 0; ai < 2; ++ai) {
            f32x4 inf[4]; int ent[4]; unsigned trw[4];
#pragma unroll
            for (int m = 0; m < 4; ++m) { ent[m] = toktab[slot * 256 + ai * 128 + wr * 64 + m * 16 + fr]; inf[m] = tokinfo[ent[m] & 0x7fffffff]; trw[m] = ((const unsigned*)(ws + WS_TOKROW))[ent[m] & 0x7fffffff]; }
#pragma unroll
            for (int m = 0; m < 4; ++m) {
                const int rr = ai * 128 + wr * 64 + m * 16 + fr;
                const bool ishi = ent[m] < 0;
                const unsigned tr = trw[m];
                const size_t prow = (size_t)tst[(tr >> 16) & 127] * 256 + (tr & 0xffffu);
                const float rs = inf[m][0] * (1.f / SW_GU), gs = (ishi ? inf[m][2] : inf[m][1]) * SA_A;
                const float rsn = -rs * LOG2E, cc = gs * rs * rs;
                f32x4 o[2];
#pragma unroll
                for (int n = 0; n < 2; ++n) {
                    const f32x4 g4 = acc[ai][0][m][n], u4 = acc[ai][1][m][n];
                    f32x4 e4 = g4 * rsn;
#pragma unroll
                    for (int i = 0; i < 4; ++i) e4[i] = __builtin_amdgcn_exp2f(e4[i]);
                    e4 = e4 + 1.f;
#pragma unroll
                    for (int i = 0; i < 4; ++i) e4[i] = __builtin_amdgcn_rcpf(e4[i]);
                    o[n] = ((g4 * u4) * cc) * e4;
                }
                if (rr < rows) { typedef unsigned u32x2 __attribute__((ext_vector_type(2))); u32x2 w8; w8.x = pk4_fp8(o[0][0], o[0][1], o[0][2], o[0][3]); w8.y = pk4_fp8(o[1][0], o[1][1], o[1][2], o[1][3]);
                  __builtin_nontemporal_store(w8, (u32x2*)(abuf + prow * 1024 + (ishi ? 512 : 0) + pn * 128 + 32 * wc + 8 * fq)); }
            }
            asm volatile("" ::: "memory");
        }
    }
};
struct EpiDown {
    static constexpr int NSTORE = 0;
    static constexpr bool HAS_MID = false; int l;
    __device__ __forceinline__ void operator()(const f32x4 (&acc)[2][2][4][2], const pg::Unit& u, int ui, int wr, int wc, int fr, int fq) const {
        asm volatile("" : "+v"(fr), "+v"(fq));
        unsigned char* ws = K_WS(); float* xout = K_OUT();
        const bf16_t* xb = (const bf16_t*)(ws + WS_XB1); bf16_t* xn = (bf16_t*)(ws + WS_XN); float* ssq = (float*)(ws + WS_SSQ2);
        const bool lastl = (l + 1 == DEPTH);
        volatile LAS int* toktab = (volatile LAS int*)LDSP(TOK_OFF);
        const int slot = u.slot, pn = u.pn, rows = utab_get(slot, 3);
#pragma unroll
        for (int ai = 0; ai < 2; ++ai) {
            int tok[4]; u32x4 xv[4][2];
#pragma unroll
            for (int m = 0; m < 4; ++m) { const int rr = ai * 128 + wr * 64 + m * 16 + fr; tok[m] = toktab[slot * 256 + rr];
#pragma unroll
                for (int bj = 0; bj < 2; ++bj) xv[m][bj] = *(const u32x4*)(xb + (size_t)tok[m] * D + pn * 256 + 128 * bj + 32 * wc + 8 * fq); }
#pragma unroll
            for (int m = 0; m < 4; ++m) {
                const int rr = ai * 128 + wr * 64 + m * 16 + fr;
                const bool ok = rr < rows; float ss = 0.f;
#pragma unroll
                for (int bj = 0; bj < 2; ++bj) {
                    const size_t off = (size_t)tok[m] * D + pn * 256 + 128 * bj + 32 * wc + 8 * fq;
                    const u32x4 w = xv[m][bj];
                    const f32x4 o0 = acc[ai][bj][m][0] * (1.f / (SW_DN * SA_A)) + (f32x4){bflo(w.x), bfhi(w.x), bflo(w.y), bfhi(w.y)}, o1 = acc[ai][bj][m][1] * (1.f / (SW_DN * SA_A)) + (f32x4){bflo(w.z), bfhi(w.z), bflo(w.w), bfhi(w.w)};
                    if (ok) {
                        if (lastl) { __builtin_nontemporal_store(o0, (f32x4*)(xout + off)); __builtin_nontemporal_store(o1, (f32x4*)(xout + off + 4)); }
                        else *(u32x4*)(xn + off) = pack8(o0, o1);
                    }
                    { const f32x4 q4 = o0 * o0 + o1 * o1; ss += (q4[0] + q4[1]) + (q4[2] + q4[3]); }
                }
                ss += __shfl_xor(ss, 16); ss += __shfl_xor(ss, 32);
                if (ok && !lastl && fq == 0) ssq[(size_t)tok[m] * 16 + pn * 4 + wc] = ss;
            }
            asm volatile("" ::: "memory");
        }
    }
};

__constant__ double INV_FREQ[8] = {1.0, 0.19392274474868576, 0.03760603093086393, 0.007292664737217109, 0.001414213562373095, 0.0002742481756762073, 5.318295896944988e-05, 1.031338537721246e-05};
__device__ __forceinline__ int dstrow(int mode, int n) {
    if (mode == 1) { const int pn = n >> 8, w = n & 255, d = w & 63; return (pn << 8) + 128 * (d >> 5) + 32 * (w >> 6) + 16 * ((d >> 4) & 1) + 8 * ((d >> 2) & 1) + 4 * ((d >> 3) & 1) + (d & 3); }
    if (mode == 2) { const int bj = n >> 9, w = n & 511; return 256 * (w >> 7) + 128 * bj + (w & 127); }
    return n;
}
__device__ __forceinline__ void p0_item(const float* W, int N, bf16_t* WT, int pitch, const float* g, int mode, LAS float* sT, int item, int lane) {
    const int nblk = N / 64, kb = item / nblk, nb = item % nblk, k0 = 64 * kb, n0 = 64 * nb;
    const int kl = lane >> 4, n4 = lane & 15;
    f32x4 v[16];
#pragma unroll
    for (int i = 0; i < 16; ++i) v[i] = __builtin_nontemporal_load((const GAS f32x4*)(W + (size_t)(k0 + 4 * i + kl) * N + n0 + 4 * n4));
#pragma unroll
    for (int i = 0; i < 16; ++i) { const int k = 4 * i + kl; const float gv = g ? g[k0 + k] : 1.f;
#pragma unroll
        for (int e = 0; e < 4; ++e) sT[(4 * n4 + e) * 65 + k] = v[i][e] * gv; }
    LDS_WAIT(); asm volatile("" ::: "memory");
    const int c = lane & 7;
#pragma unroll
    for (int j = 0; j < 8; ++j) { const int n = (lane >> 3) + 8 * j; const LAS float* sp = sT + n * 65 + 8 * c;
        u32x4 o; o.x = pk2(sp[0], sp[1]); o.y = pk2(sp[2], sp[3]); o.z = pk2(sp[4], sp[5]); o.w = pk2(sp[6], sp[7]);
        *(GAS u32x4*)(WT + (size_t)dstrow(mode, n0 + n) * pitch + k0 + 8 * c) = o; }
    LDS_WAIT(); asm volatile("" ::: "memory");
}
__device__ __forceinline__ void p0_item8(const float* W, int N, unsigned char* WT, int pitch, const float* g, float scale, int mode, LAS float* sT, int item, int lane) {
    const int nblk = N / 64, kb = item / nblk, nb = item % nblk, k0 = 64 * kb, n0 = 64 * nb;
    const int kl = lane >> 4, n4 = lane & 15;
    f32x4 v[16];
#pragma unroll
    for (int i = 0; i < 16; ++i) v[i] = __builtin_nontemporal_load((const GAS f32x4*)(W + (size_t)(k0 + 4 * i + kl) * N + n0 + 4 * n4));
#pragma unroll
    for (int i = 0; i < 16; ++i) { const int k = 4 * i + kl; const float gv = (g ? g[k0 + k] : 1.f) * scale;
#pragma unroll
        for (int e = 0; e < 4; ++e) sT[(4 * n4 + e) * 65 + k] = v[i][e] * gv; }
    LDS_WAIT(); asm volatile("" ::: "memory");
    const int c = lane & 3;
#pragma unroll
    for (int j = 0; j < 4; ++j) { const int n = (lane >> 2) + 16 * j; const LAS float* sp = sT + n * 65 + 16 * c;
        u32x4 o; o.x = pk4_fp8(sp[0], sp[1], sp[2], sp[3]); o.y = pk4_fp8(sp[4], sp[5], sp[6], sp[7]); o.z = pk4_fp8(sp[8], sp[9], sp[10], sp[11]); o.w = pk4_fp8(sp[12], sp[13], sp[14], sp[15]);
        __builtin_nontemporal_store(o, (GAS u32x4*)(WT + (size_t)dstrow(mode, n0 + n) * pitch + k0 + 16 * c)); }
    LDS_WAIT(); asm volatile("" ::: "memory");
}
__device__ __forceinline__ void p0_prologue(Frame F) {
    asm volatile("" : "+s"(F.G), "+s"(F.vcu), "+s"(F.wave)); F.lane = lane_id(); asm volatile("" : "+v"(F.lane)); F.tid = F.wave * 64 + F.lane;
    LAS float* scr = (LAS float*)(F.lds + F.wave * 16640);
    const int gw = F.vcu * NWAVES + F.wave, NGW = F.G * NWAVES;
    constexpr int I_IN = 16 * 36, I_OUT = 16 * 16, I_GU = 16 * 16, I_DN = 8 * 16;
    constexpr int N_IN = DEPTH * I_IN, N_OUT = DEPTH * I_OUT, N_GU = DEPTH * NE * I_GU, N_DN = DEPTH * NE * I_DN;
    unsigned char* ws = K_WS();
    bf16_t* WIN = (bf16_t*)(ws + WS_WIN); bf16_t* WOUT = (bf16_t*)(ws + WS_WOUT); unsigned char* WGU8 = ws + WS_WGU8; unsigned char* WDN8 = ws + WS_WDN8;
    for (int it = gw; it < N_IN + N_OUT + N_GU + N_DN; it += NGW) {
        int r = it;
        if (r < N_IN) { const int l = r / I_IN; p0_item(IN_F(3) + (size_t)l * D * PW, PW, WIN + (size_t)l * PW * D, D, IN_F(2) + l * D, 1, scr, r % I_IN, F.lane); continue; } r -= N_IN;
        if (r < N_OUT) { const int l = r / I_OUT; const int kb = (r % I_OUT) / 16; const float* gg = kb < 8 ? IN_F(9) + l * 512 : IN_F(10) + l * 512 - 512;
            p0_item(IN_F(11) + (size_t)l * D * D, D, WOUT + (size_t)l * D * D, D, gg, 0, scr, r % I_OUT, F.lane); continue; } r -= N_OUT;
        if (r < N_GU) { const int le = r / I_GU; p0_item8(IN_F(15) + (size_t)le * D * 1024, 1024, WGU8 + (size_t)le * 1024 * D, D, IN_F(12) + (le / NE) * D, SW_GU, 2, scr, r % I_GU, F.lane); continue; } r -= N_GU;
        { const int le = r / I_DN; p0_item8(IN_F(16) + (size_t)le * DE * D, D, WDN8 + (size_t)le * D * DE, DE, nullptr, SW_DN, 0, scr, r % I_DN, F.lane); }
    }
    bf16_t* WR = (bf16_t*)(ws + WS_WR);
    for (int idx = gw * 64 + F.lane; idx < DEPTH * 64 * D; idx += NGW * 64) {
        const int l = idx / (64 * D), n = (idx / D) % 64, k = idx % D;
        float v = 0.f;
        if (n < 32) v = IN_F(14)[((size_t)l * D + k) * NE + n]; else if (n < 36) v = IN_F(13)[((size_t)l * D + k) * 4 + (n - 32)];
        WR[idx] = (bf16_t)f2bf(v * IN_F(12)[l * D + k]);
    }
    if (gw == 0) { float* gains = (float*)(ws + WS_GAINS);
        for (int idx = F.lane; idx < DEPTH * 4 * 64; idx += 64) { const int l = idx / 256, w = (idx / 64) % 4, d = idx % 64; const float* g0 = IN_F(4); const float* g1 = IN_F(5); const float* g2 = IN_F(6); const float* g3 = IN_F(7);
            gains[idx] = (w == 0 ? g0 : (w == 1 ? g1 : (w == 2 ? g2 : g3)))[l * HD + d]; } }
    unsigned* rope = (unsigned*)(ws + WS_ROPE);
    if (gw == 1 && F.lane < 8) rope[(size_t)T * 8 + F.lane] = 0x00003F80u;
    for (int idx = gw * 64 + F.lane; idx < T * 8; idx += NGW * 64) {
        const int t = idx >> 3, i = idx & 7;
        const double ang = (double)IN_I(1)[t] * INV_FREQ[i];
        const double red = ang - 6.283185307179586476925 * __builtin_rint(ang * 0.15915494309189533577);
        const float rf = (float)red;
        rope[idx] = pk2(cosf(rf), sinf(rf));
    }
    bf16_t* XN = (bf16_t*)(ws + WS_XN); float* ssq2 = (float*)(ws + WS_SSQ2);
    for (int m = gw; m < T; m += 4 * NGW) {
        f32x4 v[4][4]; float sq[4];
#pragma unroll
        for (int r = 0; r < 4; ++r) { const int mr = m + r * NGW < T ? m + r * NGW : m; const GAS f32x4* xr = (const GAS f32x4*)(IN_F(0) + (size_t)mr * D) + F.lane;
#pragma unroll
            for (int j = 0; j < 4; ++j) v[r][j] = __builtin_nontemporal_load(xr + 64 * j); }
#pragma unroll
        for (int r = 0; r < 4; ++r) { float s = 0.f;
#pragma unroll
            for (int j = 0; j < 4; ++j) s += (v[r][j].x * v[r][j].x + v[r][j].y * v[r][j].y) + (v[r][j].z * v[r][j].z + v[r][j].w * v[r][j].w);
            sq[r] = wave_sum(s); }
#pragma unroll
        for (int r = 0; r < 4; ++r) { const int mr = m + r * NGW; if (mr < T) {
            GAS unsigned long long* o8 = (GAS unsigned long long*)(XN + (size_t)mr * D) + F.lane;
#pragma unroll
            for (int j = 0; j < 4; ++j) o8[64 * j] = (unsigned long long)pk2(v[r][j].x, v[r][j].y) | ((unsigned long long)pk2(v[r][j].z, v[r][j].w) << 32);
            if (F.lane < 16) ssq2[(size_t)mr * 16 + F.lane] = (F.lane == 0) ? sq[r] : 0.f; } }
    }
}

__device__ __forceinline__ void gload16(u32x4& dst, const void* p) { asm volatile("global_load_dwordx4 %0, %1, off" : "=v"(dst) : "v"(p) : "memory"); }
typedef short s16x4 __attribute__((ext_vector_type(4)));
__device__ __forceinline__ s16x4 vtr(const LAS unsigned char* p) { return __builtin_bit_cast(s16x4, __builtin_amdgcn_ds_read_tr16_b64_v4i16((LAS s16x4*)p)); }
constexpr int AT_OST = 98560, AT_WSF = AT_OST + 8 * 4096;
static_assert(AT_WSF + 8 * 256 <= TOK_OFF + MAXU * 256 * 4, "attention LDS scratch");
struct AtU { int b, h, dil, res, m0, br; };
__device__ __forceinline__ AtU at_decode_a(int u, int pass) {
    AtU r; const int idx = u & 31, bh = pass ? (u >> 5) : (u >> 6); r.br = pass ? 0 : 1 + ((u >> 5) & 1); r.h = bh & 7; r.b = bh >> 3;
    r.dil = r.br == 0 ? 1 : (r.br == 1 ? 4 : 16);
    r.res = r.br == 0 ? 0 : (r.br == 1 ? (idx >> 3) : (idx >> 1)); r.m0 = 256 * (r.br == 0 ? idx : (r.br == 1 ? (idx & 7) : (idx & 1)));
    return r;
}
__device__ __forceinline__ AtU at_decode_b(int v) { AtU r; r.m0 = 64 * (v & 127); r.h = (v >> 7) & 1; r.b = v >> 8; r.dil = 1; r.res = 0; r.br = 3; return r; }
template <int NK, bool ISB>
__device__ __forceinline__ void at_load(const Frame& F, const AtU& u, u32x4 (&kr)[NK * 8 / NTHREADS], u32x4 (&vr)[NK * 8 / NTHREADS]) {
    const bf16_t* QKV = (const bf16_t*)(F.ws + WS_QKV);
    const bf16_t* Kp = QKV + ((size_t)u.b * 36 + (ISB ? 32 + u.h : 8 + u.h)) * SEQ * 64; const bf16_t* Vp = QKV + ((size_t)u.b * 36 + (ISB ? 34 + u.h : 16 + u.h)) * SEQ * 64;
#pragma unroll
    for (int j = 0; j < NK * 8 / NTHREADS; ++j) {
        const int p = F.tid + j * NTHREADS, key = p >> 3, ch = p & 7, m = u.m0 - 128 + key, mc = m < 0 ? 0 : m;
        const size_t o = (size_t)(mc * u.dil + u.res) * 64 + ch * 8; gload16(kr[j], Kp + o); gload16(vr[j], Vp + o);
    }
}
template <bool ISB>
__device__ __forceinline__ void at_load_q(const Frame& F, const AtU& u, u32x4 (&qf)[4]) {
    const bf16_t* QKV = (const bf16_t*)(F.ws + WS_QKV);
    const int sub = ISB ? (F.wave & 1) : F.wave, qhead = ISB ? (u.h * 4 + (F.wave >> 1)) : u.h;
    const bf16_t* qp = QKV + (((size_t)u.b * 36 + (ISB ? 24 + qhead : qhead)) * SEQ + (size_t)(u.m0 + 32 * sub + (F.lane & 31)) * u.dil + u.res) * 64 + (F.lane >> 5) * 8;
#pragma unroll
    for (int s = 0; s < 4; ++s) gload16(qf[s], qp + s * 16);
}
template <int N>
__device__ __forceinline__ void at_wait_all(u32x4 (&kr)[N], u32x4 (&vr)[N], u32x4 (&q)[4]) {
    (void)kr; (void)vr; (void)q;
    __builtin_amdgcn_sched_barrier(0); asm volatile("s_waitcnt vmcnt(0)" ::: "memory"); __builtin_amdgcn_sched_barrier(0);
}
template <int NK>
__device__ __forceinline__ void at_store(const Frame& F, const u32x4 (&kr)[NK * 8 / NTHREADS], const u32x4 (&vr)[NK * 8 / NTHREADS]) {
    constexpr int KCS = NK * 16 + 16, VDS = NK * 64 + 64, VB = 8 * KCS;
#pragma unroll
    for (int j = 0; j < NK * 8 / NTHREADS; ++j) {
        const int p = F.tid + j * NTHREADS, key = p >> 3, ch = p & 7;
        *(LAS u32x4*)(F.lds + ch * KCS + key * 16) = kr[j];
        *(LAS u32x4*)(F.lds + VB + (ch >> 2) * VDS + key * 64 + (ch & 3) * 16) = vr[j];
    }
}
template <int NK, bool ISB>
__device__ __forceinline__ void at_compute(const Frame& F, int l, const AtU& u, u32x4 (&qr)[4], u32x4 (&kr)[NK * 8 / NTHREADS], u32x4 (&vr)[NK * 8 / NTHREADS], bool has_next, const AtU& un, float sinkv) {
    constexpr int KCS = NK * 16 + 16, VDS = NK * 64 + 64;
    constexpr int KB = 0, VB = 8 * KCS;
    static_assert(VB + 2 * VDS <= AT_OST, "attention LDS image");
    unsigned char* ws = F.ws;
    LAS unsigned char* lds = F.lds;
    const int lane = F.lane, w = F.wave, qq = lane & 31, hi = lane >> 5;
    const int mchunk0 = u.m0, dil = u.dil, res = u.res, br = u.br, h = u.h;
    const size_t rowb = (size_t)u.b * SEQ;
    const int sub = ISB ? (w & 1) : w;
    const int qhead = ISB ? (h * 4 + (w >> 1)) : h;
    const int mq = mchunk0 + 32 * sub + qq;
    const size_t qrow = rowb + (size_t)mq * dil + res;
    f32x16 p[5];
    const int t0 = mchunk0 + 32 * sub - 128;
    const LAS unsigned char* kp0 = lds + KB + hi * KCS + (sub * 32 + qq) * 16;
    const bf16x8 q0 = __builtin_bit_cast(bf16x8, qr[0]), q1 = __builtin_bit_cast(bf16x8, qr[1]), q2 = __builtin_bit_cast(bf16x8, qr[2]), q3 = __builtin_bit_cast(bf16x8, qr[3]);
#define AT_KF(dst, j) do { _Pragma("unroll") for (int s_ = 0; s_ < 4; ++s_) dst[s_] = *(const LAS bf16x8*)(kp0 + (j) * 512 + 2 * s_ * KCS); } while (0)
    {
        bf16x8 ka[4], kb[4];
        AT_KF(ka, 0); AT_KF(kb, 1); __builtin_amdgcn_sched_barrier(0);
        f32x16 a0 = {}, a1 = {};
        a0 = __builtin_amdgcn_mfma_f32_32x32x16_bf16(ka[0], q0, a0, 0, 0, 0); a1 = __builtin_amdgcn_mfma_f32_32x32x16_bf16(kb[0], q0, a1, 0, 0, 0);
        a0 = __builtin_amdgcn_mfma_f32_32x32x16_bf16(ka[1], q1, a0, 0, 0, 0); a1 = __builtin_amdgcn_mfma_f32_32x32x16_bf16(kb[1], q1, a1, 0, 0, 0);
        a0 = __builtin_amdgcn_mfma_f32_32x32x16_bf16(ka[2], q2, a0, 0, 0, 0); a1 = __builtin_amdgcn_mfma_f32_32x32x16_bf16(kb[2], q2, a1, 0, 0, 0);
        a0 = __builtin_amdgcn_mfma_f32_32x32x16_bf16(ka[3], q3, a0, 0, 0, 0); a1 = __builtin_amdgcn_mfma_f32_32x32x16_bf16(kb[3], q3, a1, 0, 0, 0);
        AT_KF(ka, 2); AT_KF(kb, 3); __builtin_amdgcn_sched_barrier(0);
        p[0] = a0; p[1] = a1;
        f32x16 a2 = {}, a3 = {};
        a2 = __builtin_amdgcn_mfma_f32_32x32x16_bf16(ka[0], q0, a2, 0, 0, 0); a3 = __builtin_amdgcn_mfma_f32_32x32x16_bf16(kb[0], q0, a3, 0, 0, 0);
        a2 = __builtin_amdgcn_mfma_f32_32x32x16_bf16(ka[1], q1, a2, 0, 0, 0); a3 = __builtin_amdgcn_mfma_f32_32x32x16_bf16(kb[1], q1, a3, 0, 0, 0);
        a2 = __builtin_amdgcn_mfma_f32_32x32x16_bf16(ka[2], q2, a2, 0, 0, 0); a3 = __builtin_amdgcn_mfma_f32_32x32x16_bf16(kb[2], q2, a3, 0, 0, 0);
        a2 = __builtin_amdgcn_mfma_f32_32x32x16_bf16(ka[3], q3, a2, 0, 0, 0); a3 = __builtin_amdgcn_mfma_f32_32x32x16_bf16(kb[3], q3, a3, 0, 0, 0);
        AT_KF(ka, 4); __builtin_amdgcn_sched_barrier(0);
        p[2] = a2; p[3] = a3;
        f32x16 a4 = {};
        a4 = __builtin_amdgcn_mfma_f32_32x32x16_bf16(ka[0], q0, a4, 0, 0, 0); a4 = __builtin_amdgcn_mfma_f32_32x32x16_bf16(ka[1], q1, a4, 0, 0, 0);
        a4 = __builtin_amdgcn_mfma_f32_32x32x16_bf16(ka[2], q2, a4, 0, 0, 0); a4 = __builtin_amdgcn_mfma_f32_32x32x16_bf16(ka[3], q3, a4, 0, 0, 0);
        p[4] = a4;
    }
#undef AT_KF
    __builtin_amdgcn_sched_barrier(0);
    if (has_next) at_load_q<ISB>(F, un, qr);
#pragma unroll
    for (int r = 0; r < 16; ++r) { const int kk = (r & 3) + 8 * (r >> 2) + 4 * hi;
        if (ISB ? (kk <= qq) : (kk < qq)) p[0][r] = -INFINITY;
        if (kk > qq) p[4][r] = -INFINITY; }
    if (t0 < 0) {
        asm volatile("");
#pragma unroll
        for (int r = 0; r < 16; ++r) { p[0][r] = -INFINITY; if (t0 + 32 < 0) p[1][r] = -INFINITY; if (t0 + 64 < 0) p[2][r] = -INFINITY; if (t0 + 96 < 0) p[3][r] = -INFINITY; }
    }
    float m0 = p[0][0], m1 = p[2][0], m2 = p[4][0], m3 = p[4][1];
#pragma unroll
    for (int r = 0; r < 16; ++r) { if (r) { m0 = vmax3(m0, p[0][r], p[1][r]); m1 = vmax3(m1, p[2][r], p[3][r]); } else { m0 = vmax3(m0, m0, p[1][0]); m1 = vmax3(m1, m1, p[3][0]); } }
#pragma unroll
    for (int r = 2; r < 16; r += 2) { m2 = vmax3(m2, m2, p[4][r]); m3 = vmax3(m3, m3, p[4][r + 1]); }
    float mx = vmax3(m0, m1, vmax3(m2, m2, m3));
    mx = fmaxf(mx, __shfl_xor(mx, 32));
    float sink2 = 0.f;
    if (ISB) { sink2 = sinkv; mx = fmaxf(mx, sink2); }
    f32x16 sacc = {};
    f32x2_t nmx2; { const float nm = -mx; nmx2 = (f32x2_t){nm, nm}; }
#pragma unroll
    for (int j = 0; j < 5; ++j) {
#pragma unroll
        for (int r = 0; r < 16; r += 2) { f32x2_t d2 = {p[j][r], p[j][r + 1]}, e2; asm("v_pk_add_f32 %0, %1, %2" : "=v"(e2) : "v"(d2), "v"(nmx2));
            p[j][r] = __builtin_amdgcn_exp2f(e2[0]); p[j][r + 1] = __builtin_amdgcn_exp2f(e2[1]); }
        sacc += p[j]; }
    float ls = (((sacc[0] + sacc[1]) + (sacc[2] + sacc[3])) + ((sacc[4] + sacc[5]) + (sacc[6] + sacc[7]))) + (((sacc[8] + sacc[9]) + (sacc[10] + sacc[11])) + ((sacc[12] + sacc[13]) + (sacc[14] + sacc[15])));
    ls += __shfl_xor(ls, 32);
    if (ISB) ls += __builtin_amdgcn_exp2f(sink2 - mx);
    f32x16 o0 = {}, o1 = {};
    const LAS unsigned char* vp = lds + VB + ((lane >> 4) & 1) * 32 + (lane & 3) * 8 + (4 * hi + ((lane & 15) >> 2)) * 64 + sub * 2048;
#pragma unroll
    for (int j = 0; j < 5; ++j) {
        s16x4 va[2][4];
#pragma unroll
        for (int s2_ = 0; s2_ < 2; ++s2_) { const LAS unsigned char* vk = vp + (j * 32 + 16 * s2_) * 64; va[s2_][0] = vtr(vk); va[s2_][1] = vtr(vk + 512); va[s2_][2] = vtr(vk + VDS); va[s2_][3] = vtr(vk + VDS + 512); }
        bf16x8 pf[2];
#pragma unroll
        for (int s2_ = 0; s2_ < 2; ++s2_) { u32x4 pw; pw.x = pk2(p[j][8 * s2_ + 0], p[j][8 * s2_ + 1]); pw.y = pk2(p[j][8 * s2_ + 2], p[j][8 * s2_ + 3]); pw.z = pk2(p[j][8 * s2_ + 4], p[j][8 * s2_ + 5]); pw.w = pk2(p[j][8 * s2_ + 6], p[j][8 * s2_ + 7]); pf[s2_] = __builtin_bit_cast(bf16x8, pw); }
#pragma unroll
        for (int s2_ = 0; s2_ < 2; ++s2_) {
            const bf16x8 vf0 = (bf16x8){va[s2_][0][0], va[s2_][0][1], va[s2_][0][2], va[s2_][0][3], va[s2_][1][0], va[s2_][1][1], va[s2_][1][2], va[s2_][1][3]};
            const bf16x8 vf1 = (bf16x8){va[s2_][2][0], va[s2_][2][1], va[s2_][2][2], va[s2_][2][3], va[s2_][3][0], va[s2_][3][1], va[s2_][3][2], va[s2_][3][3]};
            o0 = __builtin_amdgcn_mfma_f32_32x32x16_bf16(pf[s2_], vf0, o0, 0, 0, 0);
            o1 = __builtin_amdgcn_mfma_f32_32x32x16_bf16(pf[s2_], vf1, o1, 0, 0, 0);
        }
    }
    at_wait_all<NK * 8 / NTHREADS>(kr, vr, qr);
    const int ch = lane & 7;
    u32x4 v1[4], v2[4]; float l1[4], l2[4];
    if (!ISB && br == 0) {
        const bf16_t* O1 = (const bf16_t*)(ws + WS_OBR); const bf16_t* O2 = O1 + (size_t)T * 512; const float* L1 = (const float*)(ws + WS_LSE); const float* L2 = L1 + (size_t)T * 8;
#pragma unroll
        for (int i = 0; i < 4; ++i) { const int sq = mchunk0 + 32 * sub + i * 8 + (lane >> 3);
            v1[i] = *(const u32x4*)(O1 + ((size_t)((u.b * 8 + h) * 4 + (sq & 3)) * (SEQ / 4) + (sq >> 2)) * 64 + ch * 8); v2[i] = *(const u32x4*)(O2 + ((size_t)((u.b * 8 + h) * 16 + (sq & 15)) * (SEQ / 16) + (sq >> 4)) * 64 + ch * 8);
            l1[i] = L1[(size_t)((u.b * 8 + h) * 4 + (sq & 3)) * (SEQ / 4) + (sq >> 2)]; l2[i] = L2[(size_t)((u.b * 8 + h) * 16 + (sq & 15)) * (SEQ / 16) + (sq >> 4)]; }
    }
    LAS float* wsf = (LAS float*)(lds + AT_WSF) + w * 64;
    if (hi == 0) { wsf[qq] = __builtin_amdgcn_rcpf(ls); wsf[32 + qq] = mx + __builtin_amdgcn_logf(ls); }
    LDS_WAIT(); asm volatile("" ::: "memory");
    LAS unsigned* stg = (LAS unsigned*)(lds + AT_OST) + w * 1024;
    float rl[16];
#pragma unroll
    for (int g = 0; g < 4; ++g) { const f32x4 t4 = *(const LAS f32x4*)(wsf + 8 * g + 4 * hi); rl[4 * g] = t4[0]; rl[4 * g + 1] = t4[1]; rl[4 * g + 2] = t4[2]; rl[4 * g + 3] = t4[3]; }
#pragma unroll
    for (int r = 0; r < 16; ++r) { const int orow = (r & 3) + 8 * (r >> 2) + 4 * hi; const float rc = rl[r];
        const float x0 = o0[r] * rc, x1 = o1[r] * rc;
        const float y0 = __builtin_bit_cast(float, __builtin_amdgcn_mov_dpp(__builtin_bit_cast(int, x0), 0xB1, 0xF, 0xF, true)), y1 = __builtin_bit_cast(float, __builtin_amdgcn_mov_dpp(__builtin_bit_cast(int, x1), 0xB1, 0xF, 0xF, true));
        const unsigned wv = (qq & 1) ? pk2(y1, x1) : pk2(x0, y0);
        stg[orow * 32 + ((qq & 1) ? 16 + (qq >> 1) : (qq >> 1))] = wv; }
    LDS_WAIT(); asm volatile("" ::: "memory");
    if (!ISB && br != 0) {
        bf16_t* OB = (bf16_t*)(ws + WS_OBR) + (size_t)(br - 1) * T * 512;
#pragma unroll
        for (int i = 0; i < 4; ++i) { const int row = i * 8 + (lane >> 3); const u32x4 v = *(const LAS u32x4*)(stg + row * 32 + ch * 4);
            const size_t orow = (size_t)((u.b * 8 + h) * dil + res) * (SEQ / dil) + (size_t)(mchunk0 + 32 * sub + row);
            __builtin_nontemporal_store(v, (u32x4*)(OB + orow * 64 + ch * 8)); }
        if (hi == 0) { float* LSE = (float*)(ws + WS_LSE) + (size_t)(br - 1) * T * 8; LSE[(size_t)((u.b * 8 + h) * dil + res) * (SEQ / dil) + mq] = mx + __builtin_amdgcn_logf(ls); }
    } else {
        bf16_t* MX = (bf16_t*)(ws + WS_MIXED); float* SSQ = (float*)(ws + (ISB ? WS_SSQB : WS_SSQA));
#pragma unroll
        for (int i = 0; i < 4; ++i) { const int row = i * 8 + (lane >> 3); const u32x4 v0 = *(const LAS u32x4*)(stg + row * 32 + ch * 4);
            const size_t grow = rowb + (size_t)(mchunk0 + 32 * sub + row);
            u32x4 wv = v0; float ss = 0.f;
            if (!ISB) {
                const float l0 = wsf[32 + row], lm = fmaxf(l0, fmaxf(l1[i], l2[i]));
                float w0 = __builtin_amdgcn_exp2f(l0 - lm), w1 = __builtin_amdgcn_exp2f(l1[i] - lm), w2 = __builtin_amdgcn_exp2f(l2[i] - lm);
                const float wi = __builtin_amdgcn_rcpf(w0 + w1 + w2); w0 *= wi; w1 *= wi; w2 *= wi;
#pragma unroll
                for (int e = 0; e < 4; ++e) { const float a = w0 * bflo(v0[e]) + w1 * bflo(v1[i][e]) + w2 * bflo(v2[i][e]), c = w0 * bfhi(v0[e]) + w1 * bfhi(v1[i][e]) + w2 * bfhi(v2[i][e]);
                    wv[e] = pk2(a, c); }
            }
#pragma unroll
            for (int e = 0; e < 4; ++e) { const float a = bflo(wv[e]), c = bfhi(wv[e]); ss += a * a + c * c; }
            ss += __shfl_xor(ss, 1); ss += __shfl_xor(ss, 2); ss += __shfl_xor(ss, 4);
            __builtin_nontemporal_store(wv, (u32x4*)(MX + grow * D + (ISB ? 512 : 0) + qhead * 64 + ch * 8));
            if (ch == 0) wsf[row] = ss; }
        LDS_WAIT(); asm volatile("" ::: "memory");
        if (lane < 32) SSQ[(size_t)qhead * T + rowb + (size_t)(mchunk0 + 32 * sub + lane)] = wsf[lane];
    }
}
template <int NK, bool ISB>
__device__ __forceinline__ void at_run(Frame F, int l, int ngroups, int pass) {
    F.ws = K_WS();
    u32x4 kr[NK * 8 / NTHREADS], vr[NK * 8 / NTHREADS], qr[4];
    const bool xm = F.G == 256;
    const int nunits = ngroups * 32;
    const int ubase = xm ? (((F.vcu >> 5) * (ngroups >> 3)) << 5) + (F.vcu & 31) : F.vcu, ustep = xm ? 32 : F.G;
    const int nr = xm ? (ngroups >> 3) : (nunits - F.vcu + F.G - 1) / F.G;
    if (nr <= 0) return;
    float sk0 = 0.f, sk1 = 0.f;
    if (ISB) { const float* sp = IN_F(8) + l * 8 + (F.wave >> 1); sk0 = sp[0] * LOG2E; sk1 = sp[4] * LOG2E; asm volatile("s_waitcnt vmcnt(0)" : "+v"(sk0), "+v"(sk1)); }
    { const AtU U = ISB ? at_decode_b(ubase) : at_decode_a(ubase, pass); at_load<NK, ISB>(F, U, kr, vr); at_load_q<ISB>(F, U, qr); at_wait_all<NK * 8 / NTHREADS>(kr, vr, qr); }
    for (int r = 0; r < nr; ++r) {
        const int u = ubase + r * ustep;
        const AtU U = ISB ? at_decode_b(u) : at_decode_a(u, pass);
        const bool has_next = r + 1 < nr;
        const AtU Un = has_next ? (ISB ? at_decode_b(u + ustep) : at_decode_a(u + ustep, pass)) : U;
        LDS_BARRIER();
        at_store<NK>(F, kr, vr);
        LDS_BARRIER();
        if (has_next) at_load<NK, ISB>(F, Un, kr, vr);
        at_compute<NK, ISB>(F, l, U, qr, kr, vr, has_next, Un, U.h ? sk1 : sk0);
    }
}
__device__ __forceinline__ void p2_attn(Frame F, int l, int pass) {
    asm volatile("" : "+s"(F.G), "+s"(F.vcu), "+s"(F.wave)); F.lane = lane_id(); asm volatile("" : "+v"(F.lane)); F.tid = F.wave * 64 + F.lane;
    if (pass == 0) { at_run<384, false>(F, l, BATCH * 8 * 2, 0); }
    else {
        at_run<384, false>(F, l, BATCH * 8, 1);
        at_run<192, true>(F, l, BATCH * 2 * 4, 1);
    }
    __syncthreads();
}
__device__ __forceinline__ void p5_router(Frame F, int l) {
    asm volatile("" : "+s"(F.G), "+s"(F.vcu), "+s"(F.wave)); F.lane = lane_id(); asm volatile("" : "+v"(F.lane)); F.tid = F.wave * 64 + F.lane;
    unsigned char* ws = K_WS();
    const bf16_t* XB1 = (const bf16_t*)(ws + WS_XB1); const bf16_t* WR = (const bf16_t*)(ws + WS_WR) + (size_t)l * 64 * D;
    const float* ssq1 = (const float*)(ws + WS_SSQ1); f32x4* tokinfo = (f32x4*)(ws + WS_TOKINFO); int* list = (int*)(ws + WS_LIST);
    gu32* gcnt = (gu32*)(ws + WS_CTL) + CW_GCNT + l * 128;
    LAS float* lg = (LAS float*)(F.lds + RING_OFF) + F.wave * (32 * 40);
    LAS int* lcnt = (LAS int*)(F.lds + CNT_OFF); LAS int* lbase = (LAS int*)(F.lds + LBASE_OFF);
    LAS int* ecl = (LAS int*)(F.lds + TOK_OFF); LAS int* ebl = ecl + 32;
    int* elist = (int*)(ws + WS_ELIST); gu32* gecnt = (gu32*)(ws + WS_CTL) + CW_ECNT + l * 32;
    const int r32 = F.lane & 31, hi = F.lane >> 5;
    constexpr int WRS_OFF = RING_OFF + 8 * 32 * 40 * 4, WRS_PITCH = 2048 + 16;
    static_assert(WRS_OFF + 36 * WRS_PITCH <= TOK_OFF, "router weight stage");
    __syncthreads();
    for (int idx = F.tid; idx < 36 * 128; idx += NTHREADS) { const int n = idx >> 7, c = idx & 127; *(LAS u32x4*)(F.lds + WRS_OFF + n * WRS_PITCH + c * 16) = *(const u32x4*)(WR + (size_t)n * D + c * 8); }
    __syncthreads();
    for (int ch = blockIdx.x; ch < T / 256; ch += F.G) {
        if (F.tid < 128) lcnt[F.tid] = 0;
        if (F.tid < 32) ecl[F.tid] = 0;
        __syncthreads();
        const int tok0 = ch * 256 + F.wave * 32;
        f32x16 c0 = {}, c1 = {};
        const bf16_t* ap = XB1 + (size_t)(tok0 + r32) * D + hi * 8;
        const LAS unsigned char* bp0 = F.lds + WRS_OFF + r32 * WRS_PITCH + hi * 16; const LAS unsigned char* bp1 = F.lds + WRS_OFF + (32 + (r32 & 3)) * WRS_PITCH + hi * 16;
        bf16x8 abuf[2][16];
#pragma unroll
        for (int j = 0; j < 16; ++j) abuf[0][j] = *(const bf16x8*)(ap + j * 16);
#pragma unroll
        for (int bt = 0; bt < 4; ++bt) {
            if (bt < 3) {
#pragma unroll
                for (int j = 0; j < 16; ++j) abuf[(bt + 1) & 1][j] = *(const bf16x8*)(ap + ((bt + 1) * 16 + j) * 16); }
#pragma unroll
            for (int j = 0; j < 16; ++j) { const int s = bt * 16 + j;
                const bf16x8 w0 = *(const LAS bf16x8*)(bp0 + s * 32), w1 = *(const LAS bf16x8*)(bp1 + s * 32);
                c0 = __builtin_amdgcn_mfma_f32_32x32x16_bf16(abuf[bt & 1][j], w0, c0, 0, 0, 0);
                c1 = __builtin_amdgcn_mfma_f32_32x32x16_bf16(abuf[bt & 1][j], w1, c1, 0, 0, 0); }
        }
#pragma unroll
        for (int r = 0; r < 16; ++r) { const int tk = (r & 3) + 8 * (r >> 2) + 4 * hi; lg[tk * 40 + r32] = c0[r]; if (r32 < 4) lg[tk * 40 + 32 + r32] = c1[r]; }
        LDS_WAIT(); asm volatile("" ::: "memory");
        int bucket = 0, rank = 0, e_lo = 0, e_hi = 0, r_lo = 0, r_hi = 0; float t_rs = 0.f, t_glo = 0.f, t_ghi = 0.f; const int tok = tok0 + r32;
        if (hi == 0) {
            float sp[16];
#pragma unroll
            for (int p = 0; p < 16; ++p) sp[p] = ssq1[(size_t)p * T + tok];
            const float rs = __builtin_amdgcn_rsqf(((((sp[0] + sp[1]) + (sp[2] + sp[3])) + ((sp[4] + sp[5]) + (sp[6] + sp[7]))) + (((sp[8] + sp[9]) + (sp[10] + sp[11])) + ((sp[12] + sp[13]) + (sp[14] + sp[15])))) * (1.f / 1024.f) + EPS);
            const LAS float* lp = lg + r32 * 40;
            const float g0 = lp[32] * rs, g1 = lp[33] * rs, g2 = lp[34] * rs, g3 = lp[35] * rs;
            int gi = 0; float gm = g0; if (g1 > gm) { gm = g1; gi = 1; } if (g2 > gm) { gm = g2; gi = 2; } if (g3 > gm) { gm = g3; gi = 3; }
            const float gtop = 1.f / (__expf(g0 - gm) + __expf(g1 - gm) + __expf(g2 - gm) + __expf(g3 - gm));
            float e[8];
#pragma unroll
            for (int j = 0; j < 8; ++j) e[j] = lp[gi * 8 + j] * rs;
            int i1 = 0; float m1 = e[0];
#pragma unroll
            for (int j = 1; j < 8; ++j) if (e[j] > m1) { m1 = e[j]; i1 = j; }
            int i2 = (i1 == 0) ? 1 : 0; float m2 = -INFINITY;
#pragma unroll
            for (int j = 0; j < 8; ++j) if (j != i1 && e[j] > m2) { m2 = e[j]; i2 = j; }
            const float w2 = __expf(m2 - m1), gate1 = gtop / (1.f + w2), gate2 = gtop * w2 / (1.f + w2);
            const int lo = i1 < i2 ? i1 : i2, hix = i1 < i2 ? i2 : i1;
            const float glo = i1 < i2 ? gate1 : gate2, ghi = i1 < i2 ? gate2 : gate1;
            bucket = gi * 28 + (lo * (15 - lo)) / 2 + (hix - lo - 1);
            t_rs = rs; t_glo = glo; t_ghi = ghi; e_lo = gi * 8 + lo; e_hi = gi * 8 + hix;
            rank = __hip_atomic_fetch_add(&lcnt[bucket], 1, __ATOMIC_RELAXED, __HIP_MEMORY_SCOPE_WORKGROUP);
            r_lo = __hip_atomic_fetch_add(&ecl[e_lo], 1, __ATOMIC_RELAXED, __HIP_MEMORY_SCOPE_WORKGROUP); r_hi = __hip_atomic_fetch_add(&ecl[e_hi], 1, __ATOMIC_RELAXED, __HIP_MEMORY_SCOPE_WORKGROUP);
        }
        __syncthreads();
        if (F.tid < NBK) { const int c = lcnt[F.tid]; lbase[F.tid] = c ? (int)__hip_atomic_fetch_add(gcnt + F.tid, (unsigned)c, __ATOMIC_RELAXED, __HIP_MEMORY_SCOPE_AGENT) : 0; }
        if (F.tid >= 128 && F.tid < 160) { const int e = F.tid - 128, c = ecl[e]; ebl[e] = c ? (int)__hip_atomic_fetch_add(gecnt + e, (unsigned)c, __ATOMIC_RELAXED, __HIP_MEMORY_SCOPE_AGENT) : 0; }
        __syncthreads();
        if (hi == 0) { const int prow = lbase[bucket] + rank;
            list[(size_t)bucket * CAP + prow] = tok;
            tokinfo[tok] = (f32x4){t_rs, t_glo, t_ghi, 0.f}; ((unsigned*)(ws + WS_TOKROW))[tok] = ((unsigned)bucket << 16) | (unsigned)prow;
            elist[(size_t)e_lo * CAP + ebl[e_lo] + r_lo] = tok; elist[(size_t)e_hi * CAP + ebl[e_hi] + r_hi] = tok | (int)0x80000000; }
        __syncthreads();
    }
}

__device__ __forceinline__ int moe_prep(Frame F, int l, int coltiles) {
    asm volatile("" : "+s"(F.G), "+s"(F.vcu), "+s"(F.wave)); F.lane = lane_id(); asm volatile("" : "+v"(F.lane)); F.tid = F.wave * 64 + F.lane;
    LAS int* cntS = (LAS int*)(F.lds + CNT_OFF); LAS int* tst = (LAS int*)(F.lds + TST_OFF); LAS int* utab = (LAS int*)(F.lds + UNIT_OFF); LAS int* toktab = (LAS int*)(F.lds + TOK_OFF);
    unsigned char* ws = K_WS();
    const int* list = (const int*)(ws + WS_LIST);
    gu32* gcnt = (gu32*)(ws + WS_CTL) + CW_GCNT + l * 128;
    __syncthreads();
    if (F.tid < NBK) cntS[F.tid] = (int)__hip_atomic_load(gcnt + F.tid, __ATOMIC_RELAXED, __HIP_MEMORY_SCOPE_AGENT);
    __syncthreads();
    if (F.tid == 0) { int s = 0; for (int b = 0; b < NBK; ++b) { tst[b] = s; s += (cntS[b] + 255) >> 8; } tst[NBK] = s; }
    __syncthreads();
    const int ntile = tst[NBK], nunits = ntile * coltiles;
    int nmine = 0;
    for (int i = 0; i < MAXU; ++i) if (i * F.G + F.vcu < nunits) nmine = i + 1;
    if (F.tid < nmine) {
        const int L = F.tid * F.G + F.vcu, tg = L / coltiles, pn = L % coltiles;
        int bk = 0; for (int b = 0; b < NBK; ++b) if (tst[b] <= tg) bk = b;
        for (int b = 0; b < NBK; ++b) if (tst[b] <= tg && tg < tst[b + 1]) bk = b;
        int rows = cntS[bk] - (tg - tst[bk]) * 256; rows = rows > 256 ? 256 : rows;
        utab[F.tid * 4 + 0] = bk; utab[F.tid * 4 + 1] = tg; utab[F.tid * 4 + 2] = pn; utab[F.tid * 4 + 3] = rows;
    }
    __syncthreads();
    for (int idx = F.tid; idx < nmine * 256; idx += NTHREADS) {
        const int i = idx >> 8, r = idx & 255; const int bk = utab[i * 4 + 0], tg = utab[i * 4 + 1], rows = utab[i * 4 + 3];
        const int rr = r < rows ? r : 0;
        toktab[idx] = list[(size_t)bk * CAP + (tg - tst[bk]) * 256 + rr];
    }
    __syncthreads();
    return nmine;
}

__device__ __forceinline__ int moe_prep_e(Frame F, int l) {
    asm volatile("" : "+s"(F.G), "+s"(F.vcu), "+s"(F.wave)); F.lane = lane_id(); asm volatile("" : "+v"(F.lane)); F.tid = F.wave * 64 + F.lane;
    LAS int* cntS = (LAS int*)(F.lds + CNT_OFF); LAS int* tst = (LAS int*)(F.lds + TST_OFF); LAS int* utab = (LAS int*)(F.lds + UNIT_OFF); LAS int* toktab = (LAS int*)(F.lds + TOK_OFF);
    LAS int* etst = (LAS int*)(F.lds + LBASE_OFF); LAS int* ecnt = etst + 40;
    unsigned char* ws = K_WS();
    const int* elist = (const int*)(ws + WS_ELIST);
    gu32* gcnt = (gu32*)(ws + WS_CTL) + CW_GCNT + l * 128; gu32* gecnt = (gu32*)(ws + WS_CTL) + CW_ECNT + l * 32;
    __syncthreads();
    if (F.tid < NBK) cntS[F.tid] = (int)__hip_atomic_load(gcnt + F.tid, __ATOMIC_RELAXED, __HIP_MEMORY_SCOPE_AGENT);
    if (F.tid >= 128 && F.tid < 160) ecnt[F.tid - 128] = (int)__hip_atomic_load(gecnt + (F.tid - 128), __ATOMIC_RELAXED, __HIP_MEMORY_SCOPE_AGENT);
    __syncthreads();
    if (F.tid == 0) { int sp = 0; for (int b = 0; b < NBK; ++b) { tst[b] = sp; sp += (cntS[b] + 255) >> 8; } tst[NBK] = sp; }
    if (F.tid == 64) { int se = 0; for (int e = 0; e < NE; ++e) { etst[e] = se; se += (ecnt[e] + 255) >> 8; } etst[NE] = se; }
    __syncthreads();
    const int nunits = etst[NE] * 4;
    int nmine = 0;
    for (int i = 0; i < MAXU; ++i) if (i * F.G + F.vcu < nunits) nmine = i + 1;
    if (F.tid < nmine) {
        const int L = F.tid * F.G + F.vcu, tile = L >> 2, pn = L & 3;
        int e = 0; for (int b = 0; b < NE; ++b) if (etst[b] <= tile && tile < etst[b + 1]) e = b;
        int rows = ecnt[e] - (tile - etst[e]) * 256; rows = rows > 256 ? 256 : rows;
        utab[F.tid * 4 + 0] = e; utab[F.tid * 4 + 1] = tile - etst[e]; utab[F.tid * 4 + 2] = pn; utab[F.tid * 4 + 3] = rows;
    }
    __syncthreads();
    for (int idx = F.tid; idx < nmine * 256; idx += NTHREADS) {
        const int i = idx >> 8, r = idx & 255; const int e = utab[i * 4 + 0], tl = utab[i * 4 + 1], rows = utab[i * 4 + 3];
        toktab[idx] = elist[(size_t)e * CAP + tl * 256 + (r < rows ? r : 0)];
    }
    __syncthreads();
    return nmine;
}

__global__ void __launch_bounds__(NTHREADS, 2) mk_fwd(Args args) {
    Frame F;
    F.lds = LDSP(0);
    F.tid = 0; F.lane = 0; F.ws = nullptr; F.wave = __builtin_amdgcn_readfirstlane((int)threadIdx.x >> 6);
    F.G = gridDim.x; { const int bx = blockIdx.x; F.vcu = (F.G % 8 == 0) ? (bx % 8) * (F.G / 8) + bx / 8 : bx; }
    volatile LAS unsigned* MISC = (volatile LAS unsigned*)LDSP(MISC_OFF);
    if (threadIdx.x < 32) MISC[threadIdx.x] = 0u;
    __syncthreads();
    if (MK_N_LAUNCHES == 1) (void)xcd_barrier_post((unsigned*)(args.ws + WS_CTL) + CW_BAR, MISC + 8);
    const int lo = args.ph_lo, hi = args.ph_hi; (void)lo; (void)hi;
#if MK_N_LAUNCHES == 1
#define IN(k) true
#else
#define IN(k) (lo <= (k) && (k) < hi)
#endif
#define SEAM(k) do { if (IN(k) && IN((k) + 1) && (k) + 1 < NPHASE) { XcdBarrier bar_; bar_.bar = (unsigned*)(K_WS() + WS_CTL) + CW_BAR; bar_.st = (volatile LAS unsigned*)LDSP(MISC_OFF) + 8; xcd_barrier(bar_, F.wave); } } while (0)

    if (IN(0)) { p0_prologue(F); }
    SEAM(0);
    for (int l = 0; l < DEPTH; ++l) {
        const int pb = 1 + PPL * l;
        if (IN(pb)) {
            int G_ = F.G, bx_ = (int)blockIdx.x; asm volatile("" : "+s"(G_), "+s"(bx_));
            DenseSched S; S.a_off = WS_XN; S.b_off = WS_WIN + (size_t)l * PW * D * 2; S.pitchB = 2048; S.nN = PW / 256; S.c = bx_; S.G = G_;
            EpiQKV E{l};
            pg::gemm_phase<EpiQKV, DenseSched, false, false>(F.lds + RING_OFF, F.wave, S, E);
        }
        SEAM(pb);
        if (IN(pb + 1)) { p2_attn(F, l, 0); }
        SEAM(pb + 1);
        if (IN(pb + 2)) { p2_attn(F, l, 1); }
        SEAM(pb + 2);
        if (IN(pb + 3)) {
            int G_ = F.G, bx_ = (int)blockIdx.x; asm volatile("" : "+s"(G_), "+s"(bx_));
            DenseSched S; S.a_off = WS_MIXED; S.b_off = WS_WOUT + (size_t)l * D * D * 2; S.pitchB = 2048; S.nN = D / 256; S.c = bx_; S.G = G_;
            EpiRes E{l};
            pg::gemm_phase<EpiRes, DenseSched, false, false>(F.lds + RING_OFF, F.wave, S, E);
        }
        SEAM(pb + 3);
        if (IN(pb + 4)) { p5_router(F, l); }
        SEAM(pb + 4);
        if (IN(pb + 5)) {
            const int nmine = moe_prep_e(F, l);
            GuSched S; S.pitchB = 1024; S.l = l; S.nmine = nmine;
            EpiGU E{l};
            pg::gemm_phase<EpiGU, GuSched, true, true>(F.lds + RING_OFF, F.wave, S, E);
        }
        SEAM(pb + 5);
        if (IN(pb + 6)) {
            const int nmine = moe_prep(F, l, 4);
            DnSched S; S.pitchB = 512; S.l = l; S.nmine = nmine;
            EpiDown E{l};
            pg::gemm_phase<EpiDown, DnSched, true, true>(F.lds + RING_OFF, F.wave, S, E);
        }
        SEAM(pb + 6);
    }
#undef IN
#undef SEAM
}

extern "C" void kernel_launch(void* const* d_in, const int* in_sizes, int n_in, void* d_out, int out_size, void* d_ws, size_t ws_size, hipStream_t stream) {
    static int grid = 0;
    if (grid == 0) {
        if (n_in != 17 || out_size != T * D || ws_size < WS_END) { fprintf(stderr, "kernel_launch: unexpected shapes (n_in %d, out %d, ws %zu); nothing launched\n", n_in, out_size, ws_size); grid = -1; return; }
        int dev = 0, cus = 0;
        if (hipGetDevice(&dev) != hipSuccess || hipDeviceGetAttribute(&cus, hipDeviceAttributeMultiprocessorCount, dev) != hipSuccess) { grid = -1; return; }
        if (hipFuncSetAttribute((const void*)mk_fwd, hipFuncAttributeMaxDynamicSharedMemorySize, LDS_BYTES) != hipSuccess) { fprintf(stderr, "kernel_launch: hipFuncSetAttribute failed\n"); grid = -1; return; }
        int per_cu = 0;
        if (hipOccupancyMaxActiveBlocksPerMultiprocessor(&per_cu, (const void*)mk_fwd, NTHREADS, LDS_BYTES) != hipSuccess || per_cu < 1) fprintf(stderr, "kernel_launch: occupancy query says %d\n", per_cu);
        (void)hipGetLastError();
        grid = cus;
    }
    if (grid < 0) return;
    (void)in_sizes;
    if (hipMemsetAsync((char*)d_ws + WS_CTL, 0, CTL_ZERO_BYTES, stream) != hipSuccess) { fprintf(stderr, "kernel_launch: memset failed\n"); return; }
    Args a{};
    for (int i = 0; i < 17; ++i) a.in[i] = d_in[i];
    a.out = (float*)d_out; a.ws = (unsigned char*)d_ws;
    if (MK_N_LAUNCHES == 1) {
        a.ph_lo = 0; a.ph_hi = NPHASE;
        hipLaunchKernelGGL(mk_fwd, dim3(grid), dim3(NTHREADS), LDS_BYTES, stream, a);
    } else {
        for (int p = 0; p < NPHASE; ++p) { a.ph_lo = p; a.ph_hi = p + 1; hipLaunchKernelGGL(mk_fwd, dim3(grid), dim3(NTHREADS), LDS_BYTES, stream, a); }
    }
}
```

```cpp
#include <hip/hip_runtime.h>
#include <cstdio>
#include <cstdint>

#ifndef MK_N_LAUNCHES
#define MK_N_LAUNCHES 1
#endif

#define LAS __attribute__((address_space(3)))
#define GAS __attribute__((address_space(1)))
typedef unsigned short bf16_t;
typedef short bf16x8 __attribute__((ext_vector_type(8)));
typedef float f32x4 __attribute__((ext_vector_type(4)));
typedef float f32x16 __attribute__((ext_vector_type(16)));
typedef unsigned u32x4 __attribute__((ext_vector_type(4)));
typedef GAS unsigned gu32;

constexpr int BATCH = 8, SEQ = 8192, T = BATCH * SEQ, D = 1024, DEPTH = 2, HD = 64, PW = 2304;
constexpr int NE = 32, DE = 512, NBK = 112, CAP = 65536;
constexpr float EPS = 1e-6f, LOG2E = 1.4426950408889634f, QSCALE = 0.125f * 1.4426950408889634f;
constexpr int NWAVES = 8, NTHREADS = 512;
constexpr int PPL = 7;
constexpr int NPHASE = 1 + PPL * DEPTH;
constexpr float SW_GU = 128.f, SW_DN = 64.f, SA_A = 16.f;
constexpr int MAXU = 12;

constexpr size_t MiB = 1u << 20;
constexpr size_t WS_CTL = 0, CTL_ZERO_BYTES = 65536;
constexpr size_t WS_ROPE = 1 * MiB;
constexpr size_t WS_SSQ1 = 5 * MiB;
constexpr size_t WS_SSQ2 = 9 * MiB;
constexpr size_t WS_TOKINFO = 13 * MiB;
constexpr size_t WS_GAINS = 15 * MiB;
constexpr size_t WS_WR = 14 * MiB;
constexpr size_t WS_LIST = 16 * MiB;
constexpr size_t WS_WIN = 44 * MiB;
constexpr size_t WS_WOUT = 53 * MiB;
constexpr size_t WS_WGU8 = 57 * MiB;
constexpr size_t WS_WDN8 = 121 * MiB;
constexpr size_t WS_XF8 = 153 * MiB;
constexpr size_t WS_TOKROW = 225 * MiB;
constexpr size_t WS_ELIST = 217 * MiB;
constexpr size_t WS_QKV = 256 * MiB;
constexpr size_t WS_MIXED = 544 * MiB;
constexpr size_t WS_XB1 = 672 * MiB;
constexpr size_t WS_XN = 800 * MiB;
constexpr size_t WS_OBR = 672 * MiB;
constexpr size_t WS_LSE = 928 * MiB;
constexpr size_t WS_SSQA = 932 * MiB;
constexpr size_t WS_SSQB = 934 * MiB;
constexpr size_t WS_END = 936 * MiB;
constexpr int CW_ECNT = 320;
constexpr int CW_GCNT = 64;
constexpr int CW_BAR = 1024;

constexpr int RING_OFF = 0, RING_BYTES = 131072;
constexpr int TOK_OFF = 131072;
constexpr int UNIT_OFF = TOK_OFF + MAXU * 256 * 4;
constexpr int CNT_OFF = UNIT_OFF + 256;
constexpr int TST_OFF = CNT_OFF + 512;
constexpr int LBASE_OFF = TST_OFF + 512;
constexpr int MISC_OFF = LBASE_OFF + 512;
constexpr int EPST_OFF = 147456;
constexpr int LDS_BYTES = 163840;
static_assert(MISC_OFF + 128 <= EPST_OFF && EPST_OFF + 8 * 2048 <= LDS_BYTES, "LDS map");

extern __shared__ __attribute__((aligned(16))) unsigned char g_lds[];
#define LDSP(off) ((LAS unsigned char*)g_lds + (off))

__device__ __forceinline__ unsigned f2bf(float f) { unsigned u = __builtin_bit_cast(unsigned, f); return (u + 0x7fffu + ((u >> 16) & 1u)) >> 16; }
typedef float f32x2_t __attribute__((ext_vector_type(2))); typedef __bf16 bf16x2_t __attribute__((ext_vector_type(2)));
__device__ __forceinline__ unsigned pk2(float lo, float hi) { const f32x2_t v = {lo, hi}; const bf16x2_t b = __builtin_convertvector(v, bf16x2_t); return __builtin_bit_cast(unsigned, b); }
__device__ __forceinline__ float bflo(unsigned w) { return __builtin_bit_cast(float, w << 16); }
__device__ __forceinline__ float bfhi(unsigned w) { return __builtin_bit_cast(float, w & 0xffff0000u); }
__device__ __forceinline__ u32x4 pack8(const f32x4& a, const f32x4& b) { u32x4 w; w.x = pk2(a[0], a[1]); w.y = pk2(a[2], a[3]); w.z = pk2(b[0], b[1]); w.w = pk2(b[2], b[3]); return w; }
typedef int i32x4 __attribute__((ext_vector_type(4))); typedef int i32x8 __attribute__((ext_vector_type(8)));
__device__ __forceinline__ unsigned pk4_fp8(float a, float b, float c, float d) { int w = __builtin_amdgcn_cvt_pk_fp8_f32(a, b, 0, false); w = __builtin_amdgcn_cvt_pk_fp8_f32(c, d, w, true); return (unsigned)w; }
__device__ __forceinline__ float xor32_f(float x, bool upper  ) { float a = x, b = x; asm volatile("s_nop 1\n\tv_permlane32_swap_b32 %0, %1" : "+v"(a), "+v"(b)); return upper ? a : b; }
__device__ __forceinline__ float sum_xor32(float x) { float a = x, b = x; asm volatile("s_nop 1\n\tv_permlane32_swap_b32 %0, %1" : "+v"(a), "+v"(b)); return a + b; }
__device__ __forceinline__ float sum_xor16(float x) { float a = x, b = x; asm volatile("s_nop 1\n\tv_permlane16_swap_b32 %0, %1" : "+v"(a), "+v"(b)); return a + b; }
__device__ __forceinline__ float vmax3(float a, float b, float c) { float d; asm("v_max3_f32 %0, %1, %2, %3" : "=v"(d) : "v"(a), "v"(b), "v"(c)); return d; }
__device__ __forceinline__ float wave_sum(float v) {
#pragma unroll
    for (int o = 1; o < 64; o <<= 1) v += __shfl_xor(v, o);
    return v;
}
#define LDS_WAIT() asm volatile("s_waitcnt lgkmcnt(0)" ::: "memory")
#define LDS_BARRIER() do { asm volatile("s_waitcnt lgkmcnt(0)" ::: "memory"); __builtin_amdgcn_s_barrier(); asm volatile("" ::: "memory"); } while (0)
__device__ __forceinline__ int lane_id() { unsigned z = 0u; asm volatile("" : "+v"(z)); return (int)__builtin_amdgcn_mbcnt_hi(~0u, __builtin_amdgcn_mbcnt_lo(~0u, z)); }

#define XB_TMO      128
#define XB_XCNT(j)  (256  + 64 * (j))
#define XB_XSUB(j)  (1280 + 64 * (j))
#define XB_XGEN(j)  (2304 + 64 * (j))
#define XB_TOP      3328
#define XB_TOPGEN   3392
#define XCD_BAR_WORDS 3456
#define XB_SPIN_CAP (1u << 24)
__device__ __forceinline__ unsigned xb_ld(unsigned* p)              { return __hip_atomic_load(p, __ATOMIC_RELAXED, __HIP_MEMORY_SCOPE_AGENT); }
__device__ __forceinline__ unsigned xb_add(unsigned* p, unsigned v) { return __hip_atomic_fetch_add(p, v, __ATOMIC_RELAXED, __HIP_MEMORY_SCOPE_AGENT); }
__device__ __forceinline__ unsigned xb_xcc_id() { return (unsigned)__builtin_amdgcn_s_getreg((3 << 11) | 20) & 0xFu; }
#define XB_SPIN(cond, bar) do { unsigned _sp = 0; while (cond) { __builtin_amdgcn_s_sleep(1); \
    if ((++_sp & 255u) == 0u) { if (xb_ld(&(bar)[XB_TMO])) break; if (_sp > XB_SPIN_CAP) { atomicAdd(&(bar)[XB_TMO], 1u); break; } } } } while (0)
struct XcdBarrier { unsigned* bar; volatile LAS unsigned* st; };
__device__ __forceinline__ XcdBarrier xcd_barrier_post(unsigned* bar, volatile LAS unsigned* st) {
    XcdBarrier b; b.bar = bar; b.st = st;
    if (threadIdx.x == 0) (void)xb_add(&bar[XB_XCNT(xb_xcc_id())], 1u);
    return b;
}
__device__ __forceinline__ void xcd_barrier_complete(unsigned* bar, unsigned x, unsigned& nloc, unsigned& nx) {
    const unsigned G = gridDim.x * gridDim.y * gridDim.z;
    unsigned sum, cnt, mine, sp = 0u;
    for (;;) {
        sum = 0u; cnt = 0u; mine = 0u;
#pragma unroll
        for (unsigned j = 0; j < 16; ++j) { const unsigned c = xb_ld(&bar[XB_XCNT(j)]); sum += c; cnt += (c > 0u) ? 1u : 0u; mine = (j == x) ? c : mine; }
        if (sum == G) break;
        __builtin_amdgcn_s_sleep(1);
        if ((++sp & 255u) == 0u) { if (xb_ld(&bar[XB_TMO])) break; if (sp > XB_SPIN_CAP) { atomicAdd(&bar[XB_TMO], 1u); break; } }
    }
    nloc = mine > 0u ? mine : 1u; nx = cnt > 0u ? cnt : 1u;
}
__device__ __forceinline__ void xcd_barrier(const XcdBarrier& b, int wave) {
    asm volatile("s_waitcnt vmcnt(0)" ::: "memory");
    __syncthreads();
    if (wave == 0 && lane_id() == 0) {
        unsigned* bar = b.bar; const unsigned bx = xb_xcc_id();
        __builtin_amdgcn_s_waitcnt(0);
        unsigned nloc = b.st[0], nx = b.st[1];
        if (nloc == 0u) { xcd_barrier_complete(bar, bx, nloc, nx); b.st[0] = nloc; b.st[1] = nx; }
        const unsigned old = xb_add(&bar[XB_XSUB(bx)], 1u);
        const unsigned gen = old / nloc;
        if (old + 1u == (gen + 1u) * nloc) {
            __builtin_amdgcn_fence(__ATOMIC_RELEASE, "agent");
            asm volatile("s_waitcnt vmcnt(0)" ::: "memory");
            const unsigned og = xb_add(&bar[XB_TOP], 1u);
            const unsigned tg = og / nx;
            if (og + 1u == (tg + 1u) * nx) xb_add(&bar[XB_TOPGEN], 1u);
            else XB_SPIN(xb_ld(&bar[XB_TOPGEN]) == tg, bar);
            __builtin_amdgcn_fence(__ATOMIC_ACQUIRE, "agent");
            xb_add(&bar[XB_XGEN(bx)], 1u);
            asm volatile("s_waitcnt vmcnt(0)" ::: "memory");
        } else {
            XB_SPIN(xb_ld(&bar[XB_XGEN(bx)]) == gen, bar);
            __builtin_amdgcn_fence(__ATOMIC_ACQUIRE, "agent");
            asm volatile("s_waitcnt vmcnt(0)" ::: "memory");
        }
    }
    __syncthreads();
}

namespace pg {
constexpr int BM = 256, BK = 64, HALF = 128, HTB = HALF * BK * 2;
__device__ __forceinline__ int lds_byte(int r, int c) { const int st = (r >> 4) * 2 + (c >> 5), rr = r & 15, cc = c & 31, ob = rr * 64 + cc * 2; return st * 1024 + (ob ^ (((ob >> 9) & 1) << 5)); }
__device__ __forceinline__ void stage_rc(int b, int& R, int& C) { const int st = b / 1024, sb = b % 1024, swz = sb ^ (((sb >> 9) & 1) << 5); R = (st >> 1) * 16 + swz / 64; C = (st & 1) * 32 + (swz % 64) / 2; }
__device__ __forceinline__ int perm32(int rho) { const int n = rho >> 4, i = rho & 15; return 8 * (i >> 2) + 4 * n + (i & 3); }
struct Unit { const char* B0; int dB1; int arow, pn, slot; };
__device__ __forceinline__ void lane_rc(int tid, int i, int& R, int& C) { stage_rc(tid * 16 + i * 8192, R, C); }

template <class Epi, class Sched, bool GATHER, bool FP8>
__device__ __forceinline__ void gemm_phase(LAS unsigned char* lds, int wid, const Sched& S, const Epi& E) {
    asm volatile("" : "+s"(wid));
    int lane = lane_id(); asm volatile("" : "+v"(lane));
    const int tid = wid * 64 + lane, wr = wid >> 2, wc = wid & 3, fr = lane & 15, fq = lane >> 4;
    constexpr int NKT = FP8 ? 8 : 16, KSPLIT = NKT / 2;
    constexpr unsigned PITCHA = FP8 ? 1024u : 2048u;
    unsigned voffA[2], voffB[2];
#pragma unroll
    for (int i = 0; i < 2; ++i) { int R, C; stage_rc(tid * 16 + i * 8192, R, C); const int Rb = (R & ~31) + perm32(R & 31); voffA[i] = (unsigned)(R * PITCHA + C * 2); voffB[i] = (unsigned)(Rb * S.pitchB + C * 2); }
    const unsigned hstepB = 128u * (unsigned)S.pitchB;
    constexpr unsigned hstepA = 128u * PITCHA;
    const unsigned ldsw = (unsigned)wid * 1024u;
    const int aoff = lds_byte(wr * 64 + fr, fq * 8), boff = lds_byte(wc * 32 + fr, fq * 8);
#define PG_SA(b, h) (((b) * 2 + (h)) * HTB)
#define PG_SB(b, h) ((4 + (b) * 2 + (h)) * HTB)
#define PG_STAGE_A(bufoff, ptr, half) do { _Pragma("unroll") for (int _i = 0; _i < 2; ++_i) { \
        const char* _src = GATHER ? ((ptr) + ga[half][_i]) : ((ptr) + (half) * hstepA + voffA[_i]); \
        __builtin_amdgcn_global_load_lds((const unsigned*)_src, (LAS unsigned*)(lds + (bufoff) + ldsw + _i * 8192), 16, 0, 0); } } while (0)
#define PG_STAGE_B(bufoff, ptr, half) do { _Pragma("unroll") for (int _i = 0; _i < 2; ++_i) \
        __builtin_amdgcn_global_load_lds((const unsigned*)((ptr) + (half) * hstepB + voffB[_i]), (LAS unsigned*)(lds + (bufoff) + ldsw + _i * 8192), 16, 0, 0); } while (0)
#define PG_LDA(dst, b, h) do { _Pragma("unroll") for (int m = 0; m < 4; ++m) _Pragma("unroll") for (int k = 0; k < 2; ++k) dst[m][k] = *(const LAS bf16x8*)(lds + PG_SA(b, h) + aoff + m * 2048 + k * 1024); } while (0)
#define PG_LDB(dst, b, h) do { _Pragma("unroll") for (int n = 0; n < 2; ++n) _Pragma("unroll") for (int k = 0; k < 2; ++k) dst[n][k] = *(const LAS bf16x8*)(lds + PG_SB(b, h) + boff + n * 2048 + k * 1024); } while (0)
#define PG_MMA(ai, bj, At, Bt) do { __builtin_amdgcn_s_setprio(1); _Pragma("unroll") for (int m = 0; m < 4; ++m) _Pragma("unroll") for (int n = 0; n < 2; ++n) _Pragma("unroll") for (int k = 0; k < 2; ++k) \
        acc[ai][bj][m][n] = __builtin_amdgcn_mfma_f32_16x16x32_bf16(Bt[n][k], At[m][k], acc[ai][bj][m][n], 0, 0, 0); __builtin_amdgcn_s_setprio(0); } while (0)
#define PG_LDA8(dst, b, h) do { _Pragma("unroll") for (int m = 0; m < 4; ++m) { const i32x4 lo_ = *(const LAS i32x4*)(lds + PG_SA(b, h) + aoff + m * 2048), hi_ = *(const LAS i32x4*)(lds + PG_SA(b, h) + aoff + m * 2048 + 1024); dst[m] = __builtin_shufflevector(lo_, hi_, 0, 1, 2, 3, 4, 5, 6, 7); } } while (0)
#define PG_LDB8(dst, b, h) do { _Pragma("unroll") for (int n = 0; n < 2; ++n) { const i32x4 lo_ = *(const LAS i32x4*)(lds + PG_SB(b, h) + boff + n * 2048), hi_ = *(const LAS i32x4*)(lds + PG_SB(b, h) + boff + n * 2048 + 1024); dst[n] = __builtin_shufflevector(lo_, hi_, 0, 1, 2, 3, 4, 5, 6, 7); } } while (0)
#define PG_MMA8(ai, bj, At, Bt) do { __builtin_amdgcn_s_setprio(1); _Pragma("unroll") for (int m = 0; m < 4; ++m) _Pragma("unroll") for (int n = 0; n < 2; ++n) \
        acc[ai][bj][m][n] = __builtin_amdgcn_mfma_scale_f32_16x16x128_f8f6f4(Bt[n], At[m], acc[ai][bj][m][n], 0, 0, 0, 0x7f7f7f7f, 0, 0x7f7f7f7f); __builtin_amdgcn_s_setprio(0); } while (0)
#define PG_WAIT_V(n) asm volatile("s_waitcnt vmcnt(" #n ")" ::: "memory")
#define PG_WAIT_L(n) asm volatile("s_waitcnt lgkmcnt(" #n ")" ::: "memory")
#define PG_WAIT_VS(after_epi) do { if constexpr (Epi::NSTORE == 16) { if (after_epi) asm volatile("s_waitcnt vmcnt(24)" ::: "memory"); else asm volatile("s_waitcnt vmcnt(8)" ::: "memory"); } else asm volatile("s_waitcnt vmcnt(8)" ::: "memory"); } while (0)
#define PG_BAR __builtin_amdgcn_s_barrier()
#define PG_SCHED __builtin_amdgcn_sched_barrier(0)
    Unit cur, nxt; int ui = 0;
    if (!S.next(0, cur)) return;
    f32x4 acc[2][2][4][2];
#pragma unroll
    for (int a = 0; a < 2; ++a)
#pragma unroll
        for (int b = 0; b < 2; ++b)
#pragma unroll
            for (int m = 0; m < 4; ++m)
#pragma unroll
                for (int n = 0; n < 2; ++n) acc[a][b][m][n] = (f32x4){0.f, 0.f, 0.f, 0.f};
    bf16x8 At[4][2], B0[2][2], B1[2][2]; i32x8 At8[4], B08[2], B18[2];
    unsigned ga[2][2] = {{0u, 0u}, {0u, 0u}};
    if constexpr (GATHER) S.aoffs(cur, tid, ga);
    if constexpr (Epi::HAS_MID) E.unit_begin(cur, 0, tid);
    const char* cA = S.abase() + (GATHER ? (size_t)0 : (size_t)cur.arow * (256u * PITCHA));
    PG_STAGE_B(PG_SB(0, 0), cur.B0, 0); PG_STAGE_B(PG_SB(0, 1), cur.B0, 1); PG_STAGE_A(PG_SA(0, 0), cA, 0); PG_STAGE_A(PG_SA(0, 1), cA, 1);
    if (wr == 1) PG_BAR;
    PG_WAIT_V(2); PG_BAR;
    PG_STAGE_B(PG_SB(1, 0), cur.B0 + 128, 0); PG_STAGE_A(PG_SA(1, 0), cA + 128, 0); PG_STAGE_B(PG_SB(1, 1), cur.B0 + 128, 1);
    PG_WAIT_V(6); PG_BAR;
    for (;;) {
        const bool has_next = S.next(ui + 1, nxt);
        if (!has_next) nxt = cur;
        const char* nA = S.abase() + (GATHER ? (size_t)0 : (size_t)nxt.arow * (256u * PITCHA));
#pragma unroll 1
        for (int t = 0; t < NKT; t += 2) {
            const bool last = (t == NKT - 2);
            if constexpr (Epi::HAS_MID) { if (t == KSPLIT) { E.mid(acc, ui & 1, wr, lane_id() & 15); PG_SCHED; } }
            const char* a1 = cA + (t + 1) * 128;
            const char* a2 = last ? nA : cA + (t + 2) * 128; const char* a3 = a2 + 128;
            const char* b2 = last ? nxt.B0 : (cur.B0 + (t + 2 < KSPLIT ? 0 : cur.dB1) + ((t + 2) & (KSPLIT - 1)) * 128);
            const char* b3 = b2 + 128;
            if constexpr (!FP8) {
            const bool aft = (t == 0) && (ui > 0);
            PG_LDB(B0, 0, 0); PG_LDB(B1, 0, 1); PG_SCHED; PG_LDA(At, 0, 0); PG_STAGE_A(PG_SA(1, 1), a1, 1);
            PG_WAIT_VS(aft); PG_WAIT_L(0); PG_BAR; PG_MMA(0, 0, At, B0); PG_MMA(0, 1, At, B1); PG_BAR; PG_SCHED;
            if constexpr (GATHER) { if (last) { S.aoffs(nxt, wid * 64 + lane_id(), ga); PG_SCHED; } }
            PG_LDA(At, 0, 1); PG_STAGE_B(PG_SB(0, 0), b2, 0); PG_STAGE_B(PG_SB(0, 1), b2, 1); PG_STAGE_A(PG_SA(0, 0), a2, 0);
            PG_WAIT_VS(aft); PG_WAIT_L(0); PG_BAR; PG_MMA(1, 0, At, B0); PG_MMA(1, 1, At, B1); PG_BAR; PG_SCHED;
            PG_LDB(B0, 1, 0); PG_LDB(B1, 1, 1); PG_SCHED; PG_LDA(At, 1, 0); PG_STAGE_A(PG_SA(0, 1), a2, 1);
            PG_WAIT_VS(aft); PG_WAIT_L(0); PG_BAR; PG_MMA(0, 0, At, B0); PG_MMA(0, 1, At, B1); PG_BAR; PG_SCHED;
            PG_LDA(At, 1, 1); PG_STAGE_B(PG_SB(1, 0), b3, 0); PG_STAGE_B(PG_SB(1, 1), b3, 1); PG_STAGE_A(PG_SA(1, 0), a3, 0);
            PG_WAIT_V(8); PG_WAIT_L(0); PG_BAR; PG_MMA(1, 0, At, B0); PG_MMA(1, 1, At, B1); PG_BAR; PG_SCHED;
            } else {
            PG_LDB8(B08, 0, 0); PG_LDB8(B18, 0, 1); PG_SCHED; PG_LDA8(At8, 0, 0); PG_STAGE_A(PG_SA(1, 1), a1, 1);
            PG_WAIT_V(8); PG_WAIT_L(0); PG_BAR; PG_MMA8(0, 0, At8, B08); PG_MMA8(0, 1, At8, B18); PG_BAR; PG_SCHED;
            if constexpr (GATHER) { if (last) { S.aoffs(nxt, wid * 64 + lane_id(), ga); PG_SCHED; } }
            PG_LDA8(At8, 0, 1); PG_STAGE_B(PG_SB(0, 0), b2, 0); PG_STAGE_B(PG_SB(0, 1), b2, 1); PG_STAGE_A(PG_SA(0, 0), a2, 0);
            PG_WAIT_V(8); PG_WAIT_L(0); PG_BAR; PG_MMA8(1, 0, At8, B08); PG_MMA8(1, 1, At8, B18); PG_BAR; PG_SCHED;
            PG_LDB8(B08, 1, 0); PG_LDB8(B18, 1, 1); PG_SCHED; PG_LDA8(At8, 1, 0); PG_STAGE_A(PG_SA(0, 1), a2, 1);
            PG_WAIT_V(8); PG_WAIT_L(0); PG_BAR; PG_MMA8(0, 0, At8, B08); PG_MMA8(0, 1, At8, B18); PG_BAR; PG_SCHED;
            PG_LDA8(At8, 1, 1); PG_STAGE_B(PG_SB(1, 0), b3, 0); PG_STAGE_B(PG_SB(1, 1), b3, 1); PG_STAGE_A(PG_SA(1, 0), a3, 0);
            PG_WAIT_V(8); PG_WAIT_L(0); PG_BAR; PG_MMA8(1, 0, At8, B08); PG_MMA8(1, 1, At8, B18); PG_BAR; PG_SCHED;
            }
        }
        if (wr == 0) PG_BAR;
        { const int ln_ = lane_id(); E(acc, cur, ui, wr, wc, ln_ & 15, ln_ >> 4); }
        if (!has_next) break;
#pragma unroll
        for (int a = 0; a < 2; ++a)
#pragma unroll
            for (int b = 0; b < 2; ++b)
#pragma unroll
                for (int m = 0; m < 4; ++m)
#pragma unroll
                    for (int n = 0; n < 2; ++n) acc[a][b][m][n] = (f32x4){0.f, 0.f, 0.f, 0.f};
        cur = nxt; cA = nA; ++ui;
        if constexpr (Epi::HAS_MID) E.unit_begin(cur, ui & 1, wid * 64 + lane_id());
        if (wr == 1) PG_BAR;
    }
    PG_WAIT_V(0);
    PG_BAR;
#undef PG_SA
#undef PG_SB
#undef PG_STAGE_A
#undef PG_STAGE_B
#undef PG_LDA
#undef PG_LDB
#undef PG_MMA
#undef PG_LDA8
#undef PG_LDB8
#undef PG_MMA8
#undef PG_WAIT_V
#undef PG_WAIT_L
#undef PG_BAR
#undef PG_SCHED
}
}

struct Args { const void* in[17]; float* out; unsigned char* ws; int ph_lo, ph_hi; };
__device__ __forceinline__ const void* karg_ld(int byte_off) {
    auto kp = __builtin_amdgcn_kernarg_segment_ptr(); unsigned long long v;
    asm volatile("s_load_dwordx2 %0, %1, %2\n\ts_waitcnt lgkmcnt(0)" : "=s"(v) : "s"(kp), "s"(byte_off) : "memory");
    return (const void*)(GAS const void*)v;
}
#define IN_F(k) ((const float*)karg_ld((k) * 8))
#define IN_I(k) ((const int*)karg_ld((k) * 8))
#define K_OUT() ((float*)karg_ld(17 * 8))
#define K_WS() ((unsigned char*)karg_ld(18 * 8))
struct Frame {
    LAS unsigned char* lds;
    int tid, lane, wave, G, vcu;
    unsigned char* ws;
};

struct DenseSched {
    size_t a_off, b_off; int pitchB, nN, c, G;
    __device__ __forceinline__ const char* abase() const { return (const char*)K_WS() + a_off; }
    __device__ __forceinline__ bool next(int i, pg::Unit& u) const {
        const int nM = T / 256, nwg = nM * nN;
        const long L = (long)i * G + c; if (L >= nwg) return false;
        int wgid = (int)L; { const int q = nwg / 8, r = nwg % 8, xcd = wgid % 8, off = wgid / 8; wgid = (xcd < r ? xcd * (q + 1) : r * (q + 1) + (xcd - r) * q) + off; }
        const int nig = 8 * nN, gid = wgid / nig, fm = gid * 8, gsz = (nM - fm) < 8 ? (nM - fm) : 8;
        u.arow = fm + ((wgid % nig) % gsz); u.pn = (wgid % nig) / gsz; u.slot = 0;
        u.B0 = (const char*)K_WS() + b_off + (size_t)u.pn * 256 * 2048; u.dB1 = 1024; return true;
    }
};
__device__ __forceinline__ void bucket_experts(int bk, int& e_lo, int& e_hi) {
    const int g = bk / 28; int p = bk % 28; int lo = 0;
#pragma unroll
    for (int k = 0; k < 7; ++k) { const int len = 7 - k; if (lo == k && p >= len) { p -= len; lo = k + 1; } }
    e_lo = g * 8 + lo; e_hi = g * 8 + lo + 1 + p;
}
__device__ __forceinline__ int utab_get(int i, int f) { return __builtin_amdgcn_readfirstlane(((volatile LAS int*)LDSP(UNIT_OFF))[i * 4 + f]); }
struct GuSched {
    int pitchB, l, nmine;
    __device__ __forceinline__ const char* abase() const { return (const char*)K_WS() + WS_XF8; }
    __device__ __forceinline__ bool next(int i, pg::Unit& u) const {
        if (i >= nmine) return false;
        const int e = utab_get(i, 0), pn = utab_get(i, 2);
        u.slot = i; u.pn = pn; u.arow = 0;
        u.B0 = (const char*)K_WS() + WS_WGU8 + (((size_t)l * NE + e) * 1024 + (size_t)pn * 256) * 1024; u.dB1 = 512; return true;
    }
    __device__ __forceinline__ void aoffs(const pg::Unit& u, int tid, unsigned (&o)[2][2]) const {
        volatile LAS int* vt = (volatile LAS int*)LDSP(TOK_OFF);
#pragma unroll
        for (int i = 0; i < 2; ++i) { int R, C; pg::lane_rc(tid, i, R, C);
#pragma unroll
            for (int ai = 0; ai < 2; ++ai) { const int tok = vt[u.slot * 256 + ai * 128 + R] & 0x7fffffff; o[ai][i] = (unsigned)(tok * 1024 + C * 2); } }
    }
};
struct DnSched {
    int pitchB, l, nmine;
    __device__ __forceinline__ const char* abase() const { return (const char*)K_WS() + WS_QKV; }
    __device__ __forceinline__ bool next(int i, pg::Unit& u) const {
        if (i >= nmine) return false;
        const int bk = utab_get(i, 0), tg = utab_get(i, 1), pn = utab_get(i, 2);
        int elo, ehi; bucket_experts(bk, elo, ehi);
        u.slot = i; u.pn = pn; u.arow = tg;
        u.B0 = (const char*)K_WS() + WS_WDN8 + (((size_t)l * NE + elo) * 1024 + (size_t)pn * 256) * 512; u.dB1 = (ehi - elo) * 1024 * 512; return true;
    }
    __device__ __forceinline__ void aoffs(const pg::Unit& u, int tid, unsigned (&o)[2][2]) const {
#pragma unroll
        for (int i = 0; i < 2; ++i) { int R, C; pg::lane_rc(tid, i, R, C);
#pragma unroll
            for (int ai = 0; ai < 2; ++ai) o[ai][i] = (unsigned)((u.arow * 256 + ai * 128 + R) * 1024 + C * 2); }
    }
};

struct EpiQKV {
    static constexpr int NSTORE = 0;
    static constexpr bool HAS_MID = false; int l;
    __device__ __forceinline__ void operator()(const f32x4 (&acc)[2][2][4][2], const pg::Unit& u, int ui, int wr, int wc, int fr, int fq) const {
        asm volatile("" : "+v"(fr), "+v"(fq));
        unsigned char* ws = K_WS();
        bf16_t* qkv = (bf16_t*)(ws + WS_QKV); const float* ssq = (const float*)(ws + WS_SSQ2); const unsigned* rope = (const unsigned*)(ws + WS_ROPE);
        const int pm = u.arow, pn = u.pn, hh = pn * 4 + wc, lane = fq * 16 + fr, wid = wr * 4 + wc;
        const bool isq = (hh < 8) || (hh >= 24 && hh < 32);
        const bool isk = (hh >= 8 && hh < 16) || (hh == 32) || (hh == 33);
        const bool normed = isq || isk;
        const int gsel = hh < 8 ? 0 : (hh < 16 ? 1 : (hh < 32 ? 2 : 3));
        const float* gp = (const float*)(ws + WS_GAINS) + (l * 4 + gsel) * 64;
        const float qs = isq ? QSCALE : 1.f;
        const int fa = fq >> 1, fb = fq & 1;
        f32x4 g[2][2];
#pragma unroll
        for (int bj = 0; bj < 2; ++bj)
#pragma unroll
            for (int n = 0; n < 2; ++n) g[bj][n] = *(const f32x4*)(gp + 32 * bj + 16 * fa + 8 * n + 4 * fb) * qs;
        f32x4 sp4[2][4];
#pragma unroll
        for (int ai = 0; ai < 2; ++ai) { const f32x4* sp = (const f32x4*)(ssq + (size_t)(pm * 256 + ai * 128 + wr * 64 + lane) * 16); sp4[ai][0] = sp[0]; sp4[ai][1] = sp[1]; sp4[ai][2] = sp[2]; sp4[ai][3] = sp[3]; }
        u32x4 rp0[4], rp1[4];
        if (normed) {
#pragma unroll
            for (int m = 0; m < 4; ++m) rp0[m] = *(const u32x4*)(rope + (size_t)(fa ? T : pm * 256 + wr * 64 + m * 16 + fr) * 8 + 4 * fb);
        }
        float rxl[2];
#pragma unroll
        for (int ai = 0; ai < 2; ++ai) { const f32x4 s4 = (sp4[ai][0] + sp4[ai][1]) + (sp4[ai][2] + sp4[ai][3]); rxl[ai] = __builtin_amdgcn_rsqf(((s4[0] + s4[1]) + (s4[2] + s4[3])) * (1.f / 1024.f) + EPS); }
#pragma unroll
        for (int ai = 0; ai < 2; ++ai) {
            if (ai == 1 && normed) {
#pragma unroll
                for (int m = 0; m < 4; ++m) rp1[m] = *(const u32x4*)(rope + (size_t)(fa ? T : pm * 256 + 128 + wr * 64 + m * 16 + fr) * 8 + 4 * fb);
            }
            u32x4 (&rp)[4] = ai ? rp1 : rp0;
            float rx[4];
#pragma unroll
            for (int m = 0; m < 4; ++m) rx[m] = __shfl(rxl[ai], m * 16 + fr);
#pragma unroll
            for (int m = 0; m < 4; ++m) {
                const int row = pm * 256 + ai * 128 + wr * 64 + m * 16 + fr;
                const f32x4 a00 = acc[ai][0][m][0], a01 = acc[ai][0][m][1], a10 = acc[ai][1][m][0], a11 = acc[ai][1][m][1];
                f32x4 v00, v01, v10, v11;
                if (normed) {
                    const f32x4 sq = (a00 * a00 + a01 * a01) + (a10 * a10 + a11 * a11);
                    float ss = (sq[0] + sq[1]) + (sq[2] + sq[3]);
                    ss = sum_xor32(sum_xor16(ss));
                    const float sc = rx[m] * __builtin_amdgcn_rsqf(rx[m] * rx[m] * ss * (1.f / 64.f) + EPS);
                    v00 = a00 * (g[0][0] * sc); v01 = a01 * (g[0][1] * sc); v10 = a10 * (g[1][0] * sc); v11 = a11 * (g[1][1] * sc);
#pragma unroll
                    for (int i = 0; i < 4; ++i) { const float c = bflo(rp[m][i]), sn = bfhi(rp[m][i]), x1 = v00[i], x2 = v01[i]; v00[i] = x1 * c - x2 * sn; v01[i] = x2 * c + x1 * sn; }
                } else { v00 = a00 * rx[m]; v01 = a01 * rx[m]; v10 = a10 * rx[m]; v11 = a11 * rx[m]; }
                { LAS unsigned char* stg = LDSP(EPST_OFF) + wid * 2048;
                  { typedef unsigned u32x2 __attribute__((ext_vector_type(2))); LAS unsigned char* sr = stg + fr * 128 + 8 * fb; const int sx = fr & 7;
                    *(LAS u32x2*)(sr + (((2 * fa) ^ sx) << 4)) = (u32x2){pk2(v00[0], v00[1]), pk2(v00[2], v00[3])}; *(LAS u32x2*)(sr + (((2 * fa + 1) ^ sx) << 4)) = (u32x2){pk2(v01[0], v01[1]), pk2(v01[2], v01[3])};
                    *(LAS u32x2*)(sr + (((4 + 2 * fa) ^ sx) << 4)) = (u32x2){pk2(v10[0], v10[1]), pk2(v10[2], v10[3])}; *(LAS u32x2*)(sr + (((5 + 2 * fa) ^ sx) << 4)) = (u32x2){pk2(v11[0], v11[1]), pk2(v11[2], v11[3])}; }
                  LDS_WAIT(); asm volatile("" ::: "memory");
                  const int row0 = pm * 256 + ai * 128 + wr * 64 + m * 16;
                  bf16_t* gp0 = qkv + (((size_t)(row0 >> 13) * 36 + hh) * SEQ + (row0 & (SEQ - 1))) * 64;
#pragma unroll
                  for (int k = 0; k < 2; ++k) { const int r16 = (lane >> 3) + 8 * k, ch = lane & 7; const u32x4 w = *(const LAS u32x4*)(stg + r16 * 128 + ((ch ^ (r16 & 7)) << 4));
                      *(u32x4*)(gp0 + r16 * 64 + ch * 8) = w; }
                  LDS_WAIT(); asm volatile("" ::: "memory"); }
            }
            asm volatile("" ::: "memory");
        }
    }
};
constexpr int NRM_OFF = TOK_OFF;
struct EpiRes {
    static constexpr int NSTORE = 0;
    static constexpr bool HAS_MID = true; int l;
    __device__ __forceinline__ void unit_begin(const pg::Unit& u, int par, int tid) const {
        unsigned char* ws = K_WS();
        const int row = u.arow * 256 + (tid >> 1), side = tid & 1;
        const float* sp = (const float*)(ws + (side ? WS_SSQB : WS_SSQA)) + row;
        float sh[8];
#pragma unroll
        for (int h = 0; h < 8; ++h) sh[h] = sp[(size_t)h * T];
        const float r = __builtin_amdgcn_rsqf((((sh[0] + sh[1]) + (sh[2] + sh[3])) + ((sh[4] + sh[5]) + (sh[6] + sh[7]))) * (1.f / 512.f) + EPS), o = __shfl_xor(r, 1);
        LAS float* tab = (LAS float*)LDSP(NRM_OFF) + par * 512;
        if (side == 0) tab[tid >> 1] = r * __builtin_amdgcn_rcpf(o); else tab[256 + (tid >> 1)] = r;
    }
    __device__ __forceinline__ void mid(f32x4 (&acc)[2][2][4][2], int par, int wr, int fr) const {
        const LAS float* tab = (const LAS float*)LDSP(NRM_OFF) + par * 512;
#pragma unroll
        for (int ai = 0; ai < 2; ++ai)
#pragma unroll
            for (int m = 0; m < 4; ++m) { const float sc = tab[ai * 128 + wr * 64 + m * 16 + fr];
#pragma unroll
                for (int bj = 0; bj < 2; ++bj)
#pragma unroll
                    for (int n = 0; n < 2; ++n) acc[ai][bj][m][n] *= sc; }
    }
    __device__ __forceinline__ void operator()(const f32x4 (&acc)[2][2][4][2], const pg::Unit& u, int ui, int wr, int wc, int fr, int fq) const {
        asm volatile("" : "+v"(fr), "+v"(fq));
        unsigned char* ws = K_WS(); const bf16_t* xnb = (const bf16_t*)(ws + WS_XN);
        bf16_t* xb = (bf16_t*)(ws + WS_XB1); float* ssq = (float*)(ws + WS_SSQ1); unsigned char* xf8 = ws + WS_XF8;
        const LAS float* rbt = (const LAS float*)LDSP(NRM_OFF) + (ui & 1) * 512 + 256;
        const int pm = u.arow, pn = u.pn;
#pragma unroll
        for (int ai = 0; ai < 2; ++ai) {
            f32x4 xv[4][2][2];
#pragma unroll
            for (int m = 0; m < 4; ++m)
#pragma unroll
                for (int bj = 0; bj < 2; ++bj) { const size_t off = (size_t)(pm * 256 + ai * 128 + wr * 64 + m * 16 + fr) * D + pn * 256 + 128 * bj + 32 * wc + 8 * fq;
                    { const u32x4 w = *(const u32x4*)(xnb + off); xv[m][bj][0] = (f32x4){bflo(w.x), bfhi(w.x), bflo(w.y), bfhi(w.y)}; xv[m][bj][1] = (f32x4){bflo(w.z), bfhi(w.z), bflo(w.w), bfhi(w.w)}; } }
            float keep = 0.f;
#pragma unroll
            for (int m = 0; m < 4; ++m) {
                const int row = pm * 256 + ai * 128 + wr * 64 + m * 16 + fr; float ss = 0.f;
                const float rb = rbt[ai * 128 + wr * 64 + m * 16 + fr];
#pragma unroll
                for (int bj = 0; bj < 2; ++bj) {
                    const size_t off = (size_t)row * D + pn * 256 + 128 * bj + 32 * wc + 8 * fq;
                    const f32x4 o0 = xv[m][bj][0] + acc[ai][bj][m][0] * rb, o1 = xv[m][bj][1] + acc[ai][bj][m][1] * rb;
                    *(u32x4*)(xb + off) = pack8(o0, o1);
                    { typedef unsigned u32x2 __attribute__((ext_vector_type(2))); u32x2 w8; w8.x = pk4_fp8(o0[0], o0[1], o0[2], o0[3]); w8.y = pk4_fp8(o1[0], o1[1], o1[2], o1[3]); *(u32x2*)(xf8 + off) = w8; }
                    { const f32x4 q4 = o0 * o0 + o1 * o1; ss += (q4[0] + q4[1]) + (q4[2] + q4[3]); }
                }
                ss += __shfl_xor(ss, 16); ss += __shfl_xor(ss, 32);
                keep = (fq == m) ? ss : keep;
            }
            ssq[(size_t)(pn * 4 + wc) * T + pm * 256 + ai * 128 + wr * 64 + fq * 16 + fr] = keep;
            asm volatile("" ::: "memory");
        }
    }
};
struct EpiGU {
    static constexpr int NSTORE = 0;
    static constexpr bool HAS_MID = false; int l;
    __device__ __forceinline__ void operator()(const f32x4 (&acc)[2][2][4][2], const pg::Unit& u, int ui, int wr, int wc, int fr, int fq) const {
        asm volatile("" : "+v"(fr), "+v"(fq));
        unsigned char* ws = K_WS();
        unsigned char* abuf = ws + WS_QKV; const f32x4* tokinfo = (const f32x4*)(ws + WS_TOKINFO);
        volatile LAS int* toktab = (volatile LAS int*)LDSP(TOK_OFF); volatile LAS int* tst = (volatile LAS int*)LDSP(TST_OFF);
        const int slot = u.slot, pn = u.pn, rows = utab_get(slot, 3);
#pragma unroll
        for (int ai = 0; ai < 2; ++ai) {
            f32x4 inf[4]; int ent[4]; unsigned trw[4];
#pragma unroll
            for (int m = 0; m < 4; ++m) { ent[m] = toktab[slot * 256 + ai * 128 + wr * 64 + m * 16 + fr]; inf[m] = tokinfo[ent[m] & 0x7fffffff]; trw[m] = ((const unsigned*)(ws + WS_TOKROW))[ent[m] & 0x7fffffff]; }
#pragma unroll
            for (int m = 0; m < 4; ++m) {
                const int rr = ai * 128 + wr * 64 + m * 16 + fr;
                const bool ishi = ent[m] < 0;
                const unsigned tr = trw[m];
                const size_t prow = (size_t)tst[(tr >> 16) & 127] * 256 + (tr & 0xffffu);
                const float rs = inf[m][0] * (1.f / SW_GU), gs = (ishi ? inf[m][2] : inf[m][1]) * SA_A;
                const float rsn = -rs * LOG2E, cc = gs * rs * rs;
                f32x4 o[2];
#pragma unroll
                for (int n = 0; n < 2; ++n) {
                    const f32x4 g4 = acc[ai][0][m][n], u4 = acc[ai][1][m][n];
                    f32x4 e4 = g4 * rsn;
#pragma unroll
                    for (int i = 0; i < 4; ++i) e4[i] = __builtin_amdgcn_exp2f(e4[i]);
                    e4 = e4 + 1.f;
#pragma unroll
                    for (int i = 0; i < 4; ++i) e4[i] = __builtin_amdgcn_rcpf(e4[i]);
                    o[n] = ((g4 * u4) * cc) * e4;
                }
                if (rr < rows) { typedef unsigned u32x2 __attribute__((ext_vector_type(2))); u32x2 w8; w8.x = pk4_fp8(o[0][0], o[0][1], o[0][2], o[0][3]); w8.y = pk4_fp8(o[1][0], o[1][1], o[1][2], o[1][3]);
                  __builtin_nontemporal_store(w8, (u32x2*)(abuf + prow * 1024 + (ishi ? 512 : 0) + pn * 128 + 32 * wc + 8 * fq)); }
            }
            asm volatile("" ::: "memory");
        }
    }
};
struct EpiDown {
    static constexpr int NSTORE = 0;
    static constexpr bool HAS_MID = false; int l;
    __device__ __forceinline__ void operator()(const f32x4 (&acc)[2][2][4][2], const pg::Unit& u, int ui, int wr, int wc, int fr, int fq) const {
        asm volatile("" : "+v"(fr), "+v"(fq));
        unsigned char* ws = K_WS(); float* xout = K_OUT();
        const bf16_t* xb = (const bf16_t*)(ws + WS_XB1); bf16_t* xn = (bf16_t*)(ws + WS_XN); float* ssq = (float*)(ws + WS_SSQ2);
        const bool lastl = (l + 1 == DEPTH);
        volatile LAS int* toktab = (volatile LAS int*)LDSP(TOK_OFF);
        const int slot = u.slot, pn = u.pn, rows = utab_get(slot, 3);
#pragma unroll
        for (int ai = 0; ai < 2; ++ai) {
            int tok[4]; u32x4 xv[4][2];
#pragma unroll
            for (int m = 0; m < 4; ++m) { const int rr = ai * 128 + wr * 64 + m * 16 + fr; tok[m] = toktab[slot * 256 + rr];
#pragma unroll
                for (int bj = 0; bj < 2; ++bj) xv[m][bj] = *(const u32x4*)(xb + (size_t)tok[m] * D + pn * 256 + 128 * bj + 32 * wc + 8 * fq); }
#pragma unroll
            for (int m = 0; m < 4; ++m) {
                const int rr = ai * 128 + wr * 64 + m * 16 + fr;
                const bool ok = rr < rows; float ss = 0.f;
#pragma unroll
                for (int bj = 0; bj < 2; ++bj) {
                    const size_t off = (size_t)tok[m] * D + pn * 256 + 128 * bj + 32 * wc + 8 * fq;
                    const u32x4 w = xv[m][bj];
                    const f32x4 o0 = acc[ai][bj][m][0] * (1.f / (SW_DN * SA_A)) + (f32x4){bflo(w.x), bfhi(w.x), bflo(w.y), bfhi(w.y)}, o1 = acc[ai][bj][m][1] * (1.f / (SW_DN * SA_A)) + (f32x4){bflo(w.z), bfhi(w.z), bflo(w.w), bfhi(w.w)};
                    if (ok) {
                        if (lastl) { __builtin_nontemporal_store(o0, (f32x4*)(xout + off)); __builtin_nontemporal_store(o1, (f32x4*)(xout + off + 4)); }
                        else *(u32x4*)(xn + off) = pack8(o0, o1);
                    }
                    { const f32x4 q4 = o0 * o0 + o1 * o1; ss += (q4[0] + q4[1]) + (q4[2] + q4[3]); }
                }
                ss += __shfl_xor(ss, 16); ss += __shfl_xor(ss, 32);
                if (ok && !lastl && fq == 0) ssq[(size_t)tok[m] * 16 + pn * 4 + wc] = ss;
            }
            asm volatile("" ::: "memory");
        }
    }
};

__constant__ double INV_FREQ[8] = {1.0, 0.19392274474868576, 0.03760603093086393, 0.007292664737217109, 0.001414213562373095, 0.0002742481756762073, 5.318295896944988e-05, 1.031338537721246e-05};
__device__ __forceinline__ int dstrow(int mode, int n) {
    if (mode == 1) { const int pn = n >> 8, w = n & 255, d = w & 63; return (pn << 8) + 128 * (d >> 5) + 32 * (w >> 6) + 16 * ((d >> 4) & 1) + 8 * ((d >> 2) & 1) + 4 * ((d >> 3) & 1) + (d & 3); }
    if (mode == 2) { const int bj = n >> 9, w = n & 511; return 256 * (w >> 7) + 128 * bj + (w & 127); }
    return n;
}
__device__ __forceinline__ void p0_item(const float* W, int N, bf16_t* WT, int pitch, const float* g, int mode, LAS float* sT, int item, int lane, bool permk = false) {
    const int nblk = N / 64, kb = item / nblk, nb = item % nblk, k0 = 64 * kb, n0 = 64 * nb;
    const int kl = lane >> 4, n4 = lane & 15;
    f32x4 v[16];
#pragma unroll
    for (int i = 0; i < 16; ++i) { const int k = 4 * i + kl, ks = permk ? ((k & 1) * 32 + (k >> 1)) : k; v[i] = __builtin_nontemporal_load((const GAS f32x4*)(W + (size_t)(k0 + ks) * N + n0 + 4 * n4)); }
#pragma unroll
    for (int i = 0; i < 16; ++i) { const int k = 4 * i + kl; const float gv = g ? g[k0 + (permk ? ((k & 1) * 32 + (k >> 1)) : k)] : 1.f;
#pragma unroll
        for (int e = 0; e < 4; ++e) sT[(4 * n4 + e) * 65 + k] = v[i][e] * gv; }
    LDS_WAIT(); asm volatile("" ::: "memory");
    const int c = lane & 7;
#pragma unroll
    for (int j = 0; j < 8; ++j) { const int n = (lane >> 3) + 8 * j; const LAS float* sp = sT + n * 65 + 8 * c;
        u32x4 o; o.x = pk2(sp[0], sp[1]); o.y = pk2(sp[2], sp[3]); o.z = pk2(sp[4], sp[5]); o.w = pk2(sp[6], sp[7]);
        *(GAS u32x4*)(WT + (size_t)dstrow(mode, n0 + n) * pitch + k0 + 8 * c) = o; }
    LDS_WAIT(); asm volatile("" ::: "memory");
}
__device__ __forceinline__ void p0_item8(const float* W, int N, unsigned char* WT, int pitch, const float* g, float scale, int mode, LAS float* sT, int item, int lane) {
    const int nblk = N / 64, kb = item / nblk, nb = item % nblk, k0 = 64 * kb, n0 = 64 * nb;
    const int kl = lane >> 4, n4 = lane & 15;
    f32x4 v[16];
#pragma unroll
    for (int i = 0; i < 16; ++i) v[i] = __builtin_nontemporal_load((const GAS f32x4*)(W + (size_t)(k0 + 4 * i + kl) * N + n0 + 4 * n4));
#pragma unroll
    for (int i = 0; i < 16; ++i) { const int k = 4 * i + kl; const float gv = (g ? g[k0 + k] : 1.f) * scale;
#pragma unroll
        for (int e = 0; e < 4; ++e) sT[(4 * n4 + e) * 65 + k] = v[i][e] * gv; }
    LDS_WAIT(); asm volatile("" ::: "memory");
    const int c = lane & 3;
#pragma unroll
    for (int j = 0; j < 4; ++j) { const int n = (lane >> 2) + 16 * j; const LAS float* sp = sT + n * 65 + 16 * c;
        u32x4 o; o.x = pk4_fp8(sp[0], sp[1], sp[2], sp[3]); o.y = pk4_fp8(sp[4], sp[5], sp[6], sp[7]); o.z = pk4_fp8(sp[8], sp[9], sp[10], sp[11]); o.w = pk4_fp8(sp[12], sp[13], sp[14], sp[15]);
        __builtin_nontemporal_store(o, (GAS u32x4*)(WT + (size_t)dstrow(mode, n0 + n) * pitch + k0 + 16 * c)); }
    LDS_WAIT(); asm volatile("" ::: "memory");
}
__device__ __forceinline__ void p0_prologue(Frame F) {
    asm volatile("" : "+s"(F.G), "+s"(F.vcu), "+s"(F.wave)); F.lane = lane_id(); asm volatile("" : "+v"(F.lane)); F.tid = F.wave * 64 + F.lane;
    LAS float* scr = (LAS float*)(F.lds + F.wave * 16640);
    const int gw = F.vcu * NWAVES + F.wave, NGW = F.G * NWAVES;
    constexpr int I_IN = 16 * 36, I_OUT = 16 * 16, I_GU = 16 * 16, I_DN = 8 * 16;
    constexpr int N_IN = DEPTH * I_IN, N_OUT = DEPTH * I_OUT, N_GU = DEPTH * NE * I_GU, N_DN = DEPTH * NE * I_DN;
    unsigned char* ws = K_WS();
    bf16_t* WIN = (bf16_t*)(ws + WS_WIN); bf16_t* WOUT = (bf16_t*)(ws + WS_WOUT); unsigned char* WGU8 = ws + WS_WGU8; unsigned char* WDN8 = ws + WS_WDN8;
    for (int it = gw; it < N_IN + N_OUT + N_GU + N_DN; it += NGW) {
        int r = it;
        if (r < N_IN) { const int l = r / I_IN; p0_item(IN_F(3) + (size_t)l * D * PW, PW, WIN + (size_t)l * PW * D, D, IN_F(2) + l * D, 1, scr, r % I_IN, F.lane); continue; } r -= N_IN;
        if (r < N_OUT) { const int l = r / I_OUT; const int kb = (r % I_OUT) / 16; const float* gg = kb < 8 ? IN_F(9) + l * 512 : IN_F(10) + l * 512 - 512;
            p0_item(IN_F(11) + (size_t)l * D * D, D, WOUT + (size_t)l * D * D, D, gg, 0, scr, r % I_OUT, F.lane, true); continue; } r -= N_OUT;
        if (r < N_GU) { const int le = r / I_GU; p0_item8(IN_F(15) + (size_t)le * D * 1024, 1024, WGU8 + (size_t)le * 1024 * D, D, IN_F(12) + (le / NE) * D, SW_GU, 2, scr, r % I_GU, F.lane); continue; } r -= N_GU;
        { const int le = r / I_DN; p0_item8(IN_F(16) + (size_t)le * DE * D, D, WDN8 + (size_t)le * D * DE, DE, nullptr, SW_DN, 0, scr, r % I_DN, F.lane); }
    }
    bf16_t* WR = (bf16_t*)(ws + WS_WR);
    for (int idx = gw * 64 + F.lane; idx < DEPTH * 64 * D; idx += NGW * 64) {
        const int l = idx / (64 * D), n = (idx / D) % 64, k = idx % D;
        float v = 0.f;
        if (n < 32) v = IN_F(14)[((size_t)l * D + k) * NE + n]; else if (n < 36) v = IN_F(13)[((size_t)l * D + k) * 4 + (n - 32)];
        WR[idx] = (bf16_t)f2bf(v * IN_F(12)[l * D + k]);
    }
    if (gw == 0) { float* gains = (float*)(ws + WS_GAINS);
        for (int idx = F.lane; idx < DEPTH * 4 * 64; idx += 64) { const int l = idx / 256, w = (idx / 64) % 4, d = idx % 64; const float* g0 = IN_F(4); const float* g1 = IN_F(5); const float* g2 = IN_F(6); const float* g3 = IN_F(7);
            gains[idx] = (w == 0 ? g0 : (w == 1 ? g1 : (w == 2 ? g2 : g3)))[l * HD + d]; } }
    unsigned* rope = (unsigned*)(ws + WS_ROPE);
    if (gw == 1 && F.lane < 8) rope[(size_t)T * 8 + F.lane] = 0x00003F80u;
    for (int idx = gw * 64 + F.lane; idx < T * 8; idx += NGW * 64) {
        const int t = idx >> 3, i = idx & 7;
        const double ang = (double)IN_I(1)[t] * INV_FREQ[i];
        const double red = ang - 6.283185307179586476925 * __builtin_rint(ang * 0.15915494309189533577);
        const float rf = (float)red;
        rope[idx] = pk2(cosf(rf), sinf(rf));
    }
    bf16_t* XN = (bf16_t*)(ws + WS_XN); float* ssq2 = (float*)(ws + WS_SSQ2);
    for (int m = gw; m < T; m += 4 * NGW) {
        f32x4 v[4][4]; float sq[4];
#pragma unroll
        for (int r = 0; r < 4; ++r) { const int mr = m + r * NGW < T ? m + r * NGW : m; const GAS f32x4* xr = (const GAS f32x4*)(IN_F(0) + (size_t)mr * D) + F.lane;
#pragma unroll
            for (int j = 0; j < 4; ++j) v[r][j] = __builtin_nontemporal_load(xr + 64 * j); }
#pragma unroll
        for (int r = 0; r < 4; ++r) { float s = 0.f;
#pragma unroll
            for (int j = 0; j < 4; ++j) s += (v[r][j].x * v[r][j].x + v[r][j].y * v[r][j].y) + (v[r][j].z * v[r][j].z + v[r][j].w * v[r][j].w);
            sq[r] = wave_sum(s); }
#pragma unroll
        for (int r = 0; r < 4; ++r) { const int mr = m + r * NGW; if (mr < T) {
            GAS unsigned long long* o8 = (GAS unsigned long long*)(XN + (size_t)mr * D) + F.lane;
#pragma unroll
            for (int j = 0; j < 4; ++j) o8[64 * j] = (unsigned long long)pk2(v[r][j].x, v[r][j].y) | ((unsigned long long)pk2(v[r][j].z, v[r][j].w) << 32);
            if (F.lane < 16) ssq2[(size_t)mr * 16 + F.lane] = (F.lane == 0) ? sq[r] : 0.f; } }
    }
}

__device__ __forceinline__ void gload16(u32x4& dst, const void* p) { asm volatile("global_load_dwordx4 %0, %1, off" : "=v"(dst) : "v"(p) : "memory"); }
typedef short s16x4 __attribute__((ext_vector_type(4)));
__device__ __forceinline__ s16x4 vtr(const LAS unsigned char* p) { return __builtin_bit_cast(s16x4, __builtin_amdgcn_ds_read_tr16_b64_v4i16((LAS s16x4*)p)); }
constexpr int AT_OST = 98560, AT_WSF = AT_OST + 8 * 4096;
static_assert(AT_WSF + 8 * 256 <= TOK_OFF + MAXU * 256 * 4, "attention LDS scratch");
struct AtU { int b, h, dil, res, m0, br; };
__device__ __forceinline__ AtU at_decode_a(int u, int pass) {
    AtU r; const int idx = u & 31, bh = pass ? (u >> 5) : (u >> 6); r.br = pass ? 0 : 1 + ((u >> 5) & 1); r.h = bh & 7; r.b = bh >> 3;
    r.dil = r.br == 0 ? 1 : (r.br == 1 ? 4 : 16);
    r.res = r.br == 0 ? 0 : (r.br == 1 ? (idx >> 3) : (idx >> 1)); r.m0 = 256 * (r.br == 0 ? idx : (r.br == 1 ? (idx & 7) : (idx & 1)));
    return r;
}
__device__ __forceinline__ AtU at_decode_b(int v) { AtU r; r.m0 = 64 * (v & 127); r.h = (v >> 7) & 1; r.b = v >> 8; r.dil = 1; r.res = 0; r.br = 3; return r; }
template <int NK, bool ISB>
__device__ __forceinline__ void at_load(const Frame& F, const AtU& u, u32x4 (&kr)[NK * 8 / NTHREADS], u32x4 (&vr)[NK * 8 / NTHREADS]) {
    const bf16_t* QKV = (const bf16_t*)(F.ws + WS_QKV);
    const bf16_t* Kp = QKV + ((size_t)u.b * 36 + (ISB ? 32 + u.h : 8 + u.h)) * SEQ * 64; const bf16_t* Vp = QKV + ((size_t)u.b * 36 + (ISB ? 34 + u.h : 16 + u.h)) * SEQ * 64;
#pragma unroll
    for (int j = 0; j < NK * 8 / NTHREADS; ++j) {
        const int p = F.tid + j * NTHREADS, key = p >> 3, ch = p & 7, m = u.m0 - 128 + key, mc = m < 0 ? 0 : m;
        const size_t o = (size_t)(mc * u.dil + u.res) * 64 + ch * 8; gload16(kr[j], Kp + o); gload16(vr[j], Vp + o);
    }
}
template <bool ISB>
__device__ __forceinline__ void at_load_q(const Frame& F, const AtU& u, u32x4 (&qf)[4]) {
    const bf16_t* QKV = (const bf16_t*)(F.ws + WS_QKV);
    const int sub = ISB ? (F.wave & 1) : F.wave, qhead = ISB ? (u.h * 4 + (F.wave >> 1)) : u.h;
    const bf16_t* qp = QKV + (((size_t)u.b * 36 + (ISB ? 24 + qhead : qhead)) * SEQ + (size_t)(u.m0 + 32 * sub + (F.lane & 31)) * u.dil + u.res) * 64 + (F.lane >> 5) * 8;
#pragma unroll
    for (int s = 0; s < 4; ++s) gload16(qf[s], qp + s * 16);
}
template <int N>
__device__ __forceinline__ void at_wait_all(u32x4 (&kr)[N], u32x4 (&vr)[N], u32x4 (&q)[4]) {
    (void)kr; (void)vr; (void)q;
    __builtin_amdgcn_sched_barrier(0); asm volatile("s_waitcnt vmcnt(0)" ::: "memory"); __builtin_amdgcn_sched_barrier(0);
}
template <int NK>
__device__ __forceinline__ void at_store(const Frame& F, const u32x4 (&kr)[NK * 8 / NTHREADS], const u32x4 (&vr)[NK * 8 / NTHREADS]) {
    constexpr int KCS = NK * 16 + 16, VDS = NK * 64 + 64, VB = 8 * KCS;
#pragma unroll
    for (int j = 0; j < NK * 8 / NTHREADS; ++j) {
        const int p = F.tid + j * NTHREADS, key = p >> 3, ch = p & 7;
        *(LAS u32x4*)(F.lds + ch * KCS + key * 16) = kr[j];
        *(LAS u32x4*)(F.lds + VB + (ch >> 2) * VDS + key * 64 + (ch & 3) * 16) = vr[j];
    }
}
template <int NK, bool ISB>
__device__ __forceinline__ void at_compute(const Frame& F, int l, const AtU& u, u32x4 (&qr)[4], u32x4 (&kr)[NK * 8 / NTHREADS], u32x4 (&vr)[NK * 8 / NTHREADS], bool has_next, const AtU& un, float sinkv) {
    constexpr int KCS = NK * 16 + 16, VDS = NK * 64 + 64;
    constexpr int KB = 0, VB = 8 * KCS;
    static_assert(VB + 2 * VDS <= AT_OST, "attention LDS image");
    unsigned char* ws = F.ws;
    LAS unsigned char* lds = F.lds;
    const int lane = F.lane, w = F.wave, qq = lane & 31, hi = lane >> 5;
    const int mchunk0 = u.m0, dil = u.dil, res = u.res, br = u.br, h = u.h;
    const size_t rowb = (size_t)u.b * SEQ;
    const int sub = ISB ? (w & 1) : w;
    const int qhead = ISB ? (h * 4 + (w >> 1)) : h;
    const int mq = mchunk0 + 32 * sub + qq;
    const size_t qrow = rowb + (size_t)mq * dil + res;
    f32x16 p[5];
    const int t0 = mchunk0 + 32 * sub - 128;
    const LAS unsigned char* kp0 = lds + KB + hi * KCS + (sub * 32 + qq) * 16;
    const bf16x8 q0 = __builtin_bit_cast(bf16x8, qr[0]), q1 = __builtin_bit_cast(bf16x8, qr[1]), q2 = __builtin_bit_cast(bf16x8, qr[2]), q3 = __builtin_bit_cast(bf16x8, qr[3]);
#define AT_KF(dst, j) do { _Pragma("unroll") for (int s_ = 0; s_ < 4; ++s_) dst[s_] = *(const LAS bf16x8*)(kp0 + (j) * 512 + 2 * s_ * KCS); } while (0)
    {
        bf16x8 ka[4], kb[4];
        AT_KF(ka, 0); AT_KF(kb, 1); __builtin_amdgcn_sched_barrier(0);
        f32x16 a0 = {}, a1 = {};
        a0 = __builtin_amdgcn_mfma_f32_32x32x16_bf16(ka[0], q0, a0, 0, 0, 0); a1 = __builtin_amdgcn_mfma_f32_32x32x16_bf16(kb[0], q0, a1, 0, 0, 0);
        a0 = __builtin_amdgcn_mfma_f32_32x32x16_bf16(ka[1], q1, a0, 0, 0, 0); a1 = __builtin_amdgcn_mfma_f32_32x32x16_bf16(kb[1], q1, a1, 0, 0, 0);
        a0 = __builtin_amdgcn_mfma_f32_32x32x16_bf16(ka[2], q2, a0, 0, 0, 0); a1 = __builtin_amdgcn_mfma_f32_32x32x16_bf16(kb[2], q2, a1, 0, 0, 0);
        a0 = __builtin_amdgcn_mfma_f32_32x32x16_bf16(ka[3], q3, a0, 0, 0, 0); a1 = __builtin_amdgcn_mfma_f32_32x32x16_bf16(kb[3], q3, a1, 0, 0, 0);
        AT_KF(ka, 2); AT_KF(kb, 3); __builtin_amdgcn_sched_barrier(0);
        p[0] = a0; p[1] = a1;
        f32x16 a2 = {}, a3 = {};
        a2 = __builtin_amdgcn_mfma_f32_32x32x16_bf16(ka[0], q0, a2, 0, 0, 0); a3 = __builtin_amdgcn_mfma_f32_32x32x16_bf16(kb[0], q0, a3, 0, 0, 0);
        a2 = __builtin_amdgcn_mfma_f32_32x32x16_bf16(ka[1], q1, a2, 0, 0, 0); a3 = __builtin_amdgcn_mfma_f32_32x32x16_bf16(kb[1], q1, a3, 0, 0, 0);
        a2 = __builtin_amdgcn_mfma_f32_32x32x16_bf16(ka[2], q2, a2, 0, 0, 0); a3 = __builtin_amdgcn_mfma_f32_32x32x16_bf16(kb[2], q2, a3, 0, 0, 0);
        a2 = __builtin_amdgcn_mfma_f32_32x32x16_bf16(ka[3], q3, a2, 0, 0, 0); a3 = __builtin_amdgcn_mfma_f32_32x32x16_bf16(kb[3], q3, a3, 0, 0, 0);
        AT_KF(ka, 4); __builtin_amdgcn_sched_barrier(0);
        p[2] = a2; p[3] = a3;
        f32x16 a4 = {};
        a4 = __builtin_amdgcn_mfma_f32_32x32x16_bf16(ka[0], q0, a4, 0, 0, 0); a4 = __builtin_amdgcn_mfma_f32_32x32x16_bf16(ka[1], q1, a4, 0, 0, 0);
        a4 = __builtin_amdgcn_mfma_f32_32x32x16_bf16(ka[2], q2, a4, 0, 0, 0); a4 = __builtin_amdgcn_mfma_f32_32x32x16_bf16(ka[3], q3, a4, 0, 0, 0);
        p[4] = a4;
    }
#undef AT_KF
    __builtin_amdgcn_sched_barrier(0);
    if (has_next) at_load_q<ISB>(F, un, qr);
#pragma unroll
    for (int r = 0; r < 16; ++r) { const int kk = (r & 3) + 8 * (r >> 2) + 4 * hi;
        if (ISB ? (kk <= qq) : (kk < qq)) p[0][r] = -INFINITY;
        if (kk > qq) p[4][r] = -INFINITY; }
    if (t0 < 0) {
        asm volatile("");
#pragma unroll
        for (int r = 0; r < 16; ++r) { p[0][r] = -INFINITY; if (t0 + 32 < 0) p[1][r] = -INFINITY; if (t0 + 64 < 0) p[2][r] = -INFINITY; if (t0 + 96 < 0) p[3][r] = -INFINITY; }
    }
    float m0 = p[0][0], m1 = p[2][0], m2 = p[4][0], m3 = p[4][1];
#pragma unroll
    for (int r = 0; r < 16; ++r) { if (r) { m0 = vmax3(m0, p[0][r], p[1][r]); m1 = vmax3(m1, p[2][r], p[3][r]); } else { m0 = vmax3(m0, m0, p[1][0]); m1 = vmax3(m1, m1, p[3][0]); } }
#pragma unroll
    for (int r = 2; r < 16; r += 2) { m2 = vmax3(m2, m2, p[4][r]); m3 = vmax3(m3, m3, p[4][r + 1]); }
    float mx = vmax3(m0, m1, vmax3(m2, m2, m3));
    mx = fmaxf(mx, __shfl_xor(mx, 32));
    float sink2 = 0.f;
    if (ISB) { sink2 = sinkv; mx = fmaxf(mx, sink2); }
    f32x16 sacc = {};
    f32x2_t nmx2; { const float nm = -mx; nmx2 = (f32x2_t){nm, nm}; }
#pragma unroll
    for (int j = 0; j < 5; ++j) {
#pragma unroll
        for (int r = 0; r < 16; r += 2) { f32x2_t d2 = {p[j][r], p[j][r + 1]}, e2; asm("v_pk_add_f32 %0, %1, %2" : "=v"(e2) : "v"(d2), "v"(nmx2));
            p[j][r] = __builtin_amdgcn_exp2f(e2[0]); p[j][r + 1] = __builtin_amdgcn_exp2f(e2[1]); }
        sacc += p[j]; }
    float ls = (((sacc[0] + sacc[1]) + (sacc[2] + sacc[3])) + ((sacc[4] + sacc[5]) + (sacc[6] + sacc[7]))) + (((sacc[8] + sacc[9]) + (sacc[10] + sacc[11])) + ((sacc[12] + sacc[13]) + (sacc[14] + sacc[15])));
    ls += __shfl_xor(ls, 32);
    if (ISB) ls += __builtin_amdgcn_exp2f(sink2 - mx);
    f32x16 o0 = {}, o1 = {};
    const LAS unsigned char* vp = lds + VB + ((lane >> 4) & 1) * 32 + (lane & 3) * 8 + (4 * hi + ((lane & 15) >> 2)) * 64 + sub * 2048;
#pragma unroll
    for (int j = 0; j < 5; ++j) {
        s16x4 va[2][4];
#pragma unroll
        for (int s2_ = 0; s2_ < 2; ++s2_) { const LAS unsigned char* vk = vp + (j * 32 + 16 * s2_) * 64; va[s2_][0] = vtr(vk); va[s2_][1] = vtr(vk + 512); va[s2_][2] = vtr(vk + VDS); va[s2_][3] = vtr(vk + VDS + 512); }
        bf16x8 pf[2];
#pragma unroll
        for (int s2_ = 0; s2_ < 2; ++s2_) { u32x4 pw; pw.x = pk2(p[j][8 * s2_ + 0], p[j][8 * s2_ + 1]); pw.y = pk2(p[j][8 * s2_ + 2], p[j][8 * s2_ + 3]); pw.z = pk2(p[j][8 * s2_ + 4], p[j][8 * s2_ + 5]); pw.w = pk2(p[j][8 * s2_ + 6], p[j][8 * s2_ + 7]); pf[s2_] = __builtin_bit_cast(bf16x8, pw); }
#pragma unroll
        for (int s2_ = 0; s2_ < 2; ++s2_) {
            const bf16x8 vf0 = (bf16x8){va[s2_][0][0], va[s2_][0][1], va[s2_][0][2], va[s2_][0][3], va[s2_][1][0], va[s2_][1][1], va[s2_][1][2], va[s2_][1][3]};
            const bf16x8 vf1 = (bf16x8){va[s2_][2][0], va[s2_][2][1], va[s2_][2][2], va[s2_][2][3], va[s2_][3][0], va[s2_][3][1], va[s2_][3][2], va[s2_][3][3]};
            o0 = __builtin_amdgcn_mfma_f32_32x32x16_bf16(pf[s2_], vf0, o0, 0, 0, 0);
            o1 = __builtin_amdgcn_mfma_f32_32x32x16_bf16(pf[s2_], vf1, o1, 0, 0, 0);
        }
    }
    at_wait_all<NK * 8 / NTHREADS>(kr, vr, qr);
    const int ch = lane & 7;
    u32x4 v1[4], v2[4]; float l1[4], l2[4];
    if (!ISB && br == 0) {
        const bf16_t* O1 = (const bf16_t*)(ws + WS_OBR); const bf16_t* O2 = O1 + (size_t)T * 512; const float* L1 = (const float*)(ws + WS_LSE); const float* L2 = L1 + (size_t)T * 8;
#pragma unroll
        for (int i = 0; i < 4; ++i) { const int sq = mchunk0 + 32 * sub + i * 8 + (lane >> 3);
            v1[i] = *(const u32x4*)(O1 + ((size_t)((u.b * 8 + h) * 4 + (sq & 3)) * (SEQ / 4) + (sq >> 2)) * 64 + ch * 8); v2[i] = *(const u32x4*)(O2 + ((size_t)((u.b * 8 + h) * 16 + (sq & 15)) * (SEQ / 16) + (sq >> 4)) * 64 + ch * 8);
            l1[i] = L1[(size_t)((u.b * 8 + h) * 4 + (sq & 3)) * (SEQ / 4) + (sq >> 2)]; l2[i] = L2[(size_t)((u.b * 8 + h) * 16 + (sq & 15)) * (SEQ / 16) + (sq >> 4)]; }
    }
    LAS float* wsf = (LAS float*)(lds + AT_WSF) + w * 64;
    if (hi == 0) { wsf[qq] = __builtin_amdgcn_rcpf(ls); wsf[32 + qq] = mx + __builtin_amdgcn_logf(ls); }
    LDS_WAIT(); asm volatile("" ::: "memory");
    LAS unsigned* stg = (LAS unsigned*)(lds + AT_OST) + w * 1024;
    float rl[16];
#pragma unroll
    for (int g = 0; g < 4; ++g) { const f32x4 t4 = *(const LAS f32x4*)(wsf + 8 * g + 4 * hi); rl[4 * g] = t4[0]; rl[4 * g + 1] = t4[1]; rl[4 * g + 2] = t4[2]; rl[4 * g + 3] = t4[3]; }
#pragma unroll
    for (int r = 0; r < 16; ++r) { const int orow = (r & 3) + 8 * (r >> 2) + 4 * hi; const float rc = rl[r];
        float a0_, a1_; asm("v_mul_f32 %0, %1, %2" : "=v"(a0_) : "v"(o0[r]), "v"(rc)); asm("v_mul_f32 %0, %1, %2" : "=v"(a1_) : "v"(o1[r]), "v"(rc));
        stg[orow * 32 + qq] = pk2(a0_, a1_); }
    LDS_WAIT(); asm volatile("" ::: "memory");
    if (!ISB && br != 0) {
        bf16_t* OB = (bf16_t*)(ws + WS_OBR) + (size_t)(br - 1) * T * 512;
#pragma unroll
        for (int i = 0; i < 4; ++i) { const int row = i * 8 + (lane >> 3); const u32x4 v = *(const LAS u32x4*)(stg + row * 32 + ch * 4);
            const size_t orow = (size_t)((u.b * 8 + h) * dil + res) * (SEQ / dil) + (size_t)(mchunk0 + 32 * sub + row);
            __builtin_nontemporal_store(v, (u32x4*)(OB + orow * 64 + ch * 8)); }
        if (hi == 0) { float* LSE = (float*)(ws + WS_LSE) + (size_t)(br - 1) * T * 8; LSE[(size_t)((u.b * 8 + h) * dil + res) * (SEQ / dil) + mq] = mx + __builtin_amdgcn_logf(ls); }
    } else {
        bf16_t* MX = (bf16_t*)(ws + WS_MIXED); float* SSQ = (float*)(ws + (ISB ? WS_SSQB : WS_SSQA));
#pragma unroll
        for (int i = 0; i < 4; ++i) { const int row = i * 8 + (lane >> 3); const u32x4 v0 = *(const LAS u32x4*)(stg + row * 32 + ch * 4);
            const size_t grow = rowb + (size_t)(mchunk0 + 32 * sub + row);
            u32x4 wv = v0; float ss = 0.f;
            if (!ISB) {
                const float l0 = wsf[32 + row], lm = fmaxf(l0, fmaxf(l1[i], l2[i]));
                float w0 = __builtin_amdgcn_exp2f(l0 - lm), w1 = __builtin_amdgcn_exp2f(l1[i] - lm), w2 = __builtin_amdgcn_exp2f(l2[i] - lm);
                const float wi = __builtin_amdgcn_rcpf(w0 + w1 + w2); w0 *= wi; w1 *= wi; w2 *= wi;
#pragma unroll
                for (int e = 0; e < 4; ++e) { const float a = w0 * bflo(v0[e]) + w1 * bflo(v1[i][e]) + w2 * bflo(v2[i][e]), c = w0 * bfhi(v0[e]) + w1 * bfhi(v1[i][e]) + w2 * bfhi(v2[i][e]);
                    wv[e] = pk2(a, c); }
            }
#pragma unroll
            for (int e = 0; e < 4; ++e) { const float a = bflo(wv[e]), c = bfhi(wv[e]); ss += a * a + c * c; }
            ss += __shfl_xor(ss, 1); ss += __shfl_xor(ss, 2); ss += __shfl_xor(ss, 4);
            __builtin_nontemporal_store(wv, (u32x4*)(MX + grow * D + (ISB ? 512 : 0) + qhead * 64 + ch * 8));
            if (ch == 0) wsf[row] = ss; }
        LDS_WAIT(); asm volatile("" ::: "memory");
        if (lane < 32) SSQ[(size_t)qhead * T + rowb + (size_t)(mchunk0 + 32 * sub + lane)] = wsf[lane];
    }
}
template <int NK, bool ISB>
__device__ __forceinline__ void at_run(Frame F, int l, int ngroups, int pass) {
    F.ws = K_WS();
    u32x4 kr[NK * 8 / NTHREADS], vr[NK * 8 / NTHREADS], qr[4];
    const bool xm = F.G == 256;
    const int nunits = ngroups * 32;
    const int ubase = xm ? (((F.vcu >> 5) * (ngroups >> 3)) << 5) + (F.vcu & 31) : F.vcu, ustep = xm ? 32 : F.G;
    const int nr = xm ? (ngroups >> 3) : (nunits - F.vcu + F.G - 1) / F.G;
    if (nr <= 0) return;
    float sk0 = 0.f, sk1 = 0.f;
    if (ISB) { const float* sp = IN_F(8) + l * 8 + (F.wave >> 1); sk0 = sp[0] * LOG2E; sk1 = sp[4] * LOG2E; asm volatile("s_waitcnt vmcnt(0)" : "+v"(sk0), "+v"(sk1)); }
    { const AtU U = ISB ? at_decode_b(ubase) : at_decode_a(ubase, pass); at_load<NK, ISB>(F, U, kr, vr); at_load_q<ISB>(F, U, qr); at_wait_all<NK * 8 / NTHREADS>(kr, vr, qr); }
    for (int r = 0; r < nr; ++r) {
        const int u = ubase + r * ustep;
        const AtU U = ISB ? at_decode_b(u) : at_decode_a(u, pass);
        const bool has_next = r + 1 < nr;
        const AtU Un = has_next ? (ISB ? at_decode_b(u + ustep) : at_decode_a(u + ustep, pass)) : U;
        LDS_BARRIER();
        at_store<NK>(F, kr, vr);
        LDS_BARRIER();
        if (has_next) at_load<NK, ISB>(F, Un, kr, vr);
        at_compute<NK, ISB>(F, l, U, qr, kr, vr, has_next, Un, U.h ? sk1 : sk0);
    }
}
__device__ __forceinline__ void p2_attn(Frame F, int l, int pass) {
    asm volatile("" : "+s"(F.G), "+s"(F.vcu), "+s"(F.wave)); F.lane = lane_id(); asm volatile("" : "+v"(F.lane)); F.tid = F.wave * 64 + F.lane;
    if (pass == 0) { at_run<384, false>(F, l, BATCH * 8 * 2, 0); }
    else {
        at_run<384, false>(F, l, BATCH * 8, 1);
        at_run<192, true>(F, l, BATCH * 2 * 4, 1);
    }
    __syncthreads();
}
__device__ __forceinline__ void p5_router(Frame F, int l) {
    asm volatile("" : "+s"(F.G), "+s"(F.vcu), "+s"(F.wave)); F.lane = lane_id(); asm volatile("" : "+v"(F.lane)); F.tid = F.wave * 64 + F.lane;
    unsigned char* ws = K_WS();
    const bf16_t* XB1 = (const bf16_t*)(ws + WS_XB1); const bf16_t* WR = (const bf16_t*)(ws + WS_WR) + (size_t)l * 64 * D;
    const float* ssq1 = (const float*)(ws + WS_SSQ1); f32x4* tokinfo = (f32x4*)(ws + WS_TOKINFO); int* list = (int*)(ws + WS_LIST);
    gu32* gcnt = (gu32*)(ws + WS_CTL) + CW_GCNT + l * 128;
    LAS float* lg = (LAS float*)(F.lds + RING_OFF) + F.wave * (32 * 40);
    LAS int* lcnt = (LAS int*)(F.lds + CNT_OFF); LAS int* lbase = (LAS int*)(F.lds + LBASE_OFF);
    LAS int* ecl = (LAS int*)(F.lds + TOK_OFF); LAS int* ebl = ecl + 32;
    int* elist = (int*)(ws + WS_ELIST); gu32* gecnt = (gu32*)(ws + WS_CTL) + CW_ECNT + l * 32;
    const int r32 = F.lane & 31, hi = F.lane >> 5;
    constexpr int WRS_OFF = RING_OFF + 8 * 32 * 40 * 4, WRS_PITCH = 2048 + 16;
    static_assert(WRS_OFF + 36 * WRS_PITCH <= TOK_OFF, "router weight stage");
    __syncthreads();
    for (int idx = F.tid; idx < 36 * 128; idx += NTHREADS) { const int n = idx >> 7, c = idx & 127; *(LAS u32x4*)(F.lds + WRS_OFF + n * WRS_PITCH + c * 16) = *(const u32x4*)(WR + (size_t)n * D + c * 8); }
    __syncthreads();
    for (int ch = blockIdx.x; ch < T / 256; ch += F.G) {
        if (F.tid < 128) lcnt[F.tid] = 0;
        if (F.tid < 32) ecl[F.tid] = 0;
        __syncthreads();
        const int tok0 = ch * 256 + F.wave * 32;
        f32x16 c0 = {}, c1 = {};
        const bf16_t* ap = XB1 + (size_t)(tok0 + r32) * D + hi * 8;
        const LAS unsigned char* bp0 = F.lds + WRS_OFF + r32 * WRS_PITCH + hi * 16; const LAS unsigned char* bp1 = F.lds + WRS_OFF + (32 + (r32 & 3)) * WRS_PITCH + hi * 16;
        bf16x8 abuf[2][16];
#pragma unroll
        for (int j = 0; j < 16; ++j) abuf[0][j] = *(const bf16x8*)(ap + j * 16);
#pragma unroll
        for (int bt = 0; bt < 4; ++bt) {
            if (bt < 3) {
#pragma unroll
                for (int j = 0; j < 16; ++j) abuf[(bt + 1) & 1][j] = *(const bf16x8*)(ap + ((bt + 1) * 16 + j) * 16); }
#pragma unroll
            for (int j = 0; j < 16; ++j) { const int s = bt * 16 + j;
                const bf16x8 w0 = *(const LAS bf16x8*)(bp0 + s * 32), w1 = *(const LAS bf16x8*)(bp1 + s * 32);
                c0 = __builtin_amdgcn_mfma_f32_32x32x16_bf16(abuf[bt & 1][j], w0, c0, 0, 0, 0);
                c1 = __builtin_amdgcn_mfma_f32_32x32x16_bf16(abuf[bt & 1][j], w1, c1, 0, 0, 0); }
        }
#pragma unroll
        for (int r = 0; r < 16; ++r) { const int tk = (r & 3) + 8 * (r >> 2) + 4 * hi; lg[tk * 40 + r32] = c0[r]; if (r32 < 4) lg[tk * 40 + 32 + r32] = c1[r]; }
        LDS_WAIT(); asm volatile("" ::: "memory");
        int bucket = 0, rank = 0, e_lo = 0, e_hi = 0, r_lo = 0, r_hi = 0; float t_rs = 0.f, t_glo = 0.f, t_ghi = 0.f; const int tok = tok0 + r32;
        if (hi == 0) {
            float sp[16];
#pragma unroll
            for (int p = 0; p < 16; ++p) sp[p] = ssq1[(size_t)p * T + tok];
            const float rs = __builtin_amdgcn_rsqf(((((sp[0] + sp[1]) + (sp[2] + sp[3])) + ((sp[4] + sp[5]) + (sp[6] + sp[7]))) + (((sp[8] + sp[9]) + (sp[10] + sp[11])) + ((sp[12] + sp[13]) + (sp[14] + sp[15])))) * (1.f / 1024.f) + EPS);
            const LAS float* lp = lg + r32 * 40;
            const float g0 = lp[32] * rs, g1 = lp[33] * rs, g2 = lp[34] * rs, g3 = lp[35] * rs;
            int gi = 0; float gm = g0; if (g1 > gm) { gm = g1; gi = 1; } if (g2 > gm) { gm = g2; gi = 2; } if (g3 > gm) { gm = g3; gi = 3; }
            const float gtop = 1.f / (__expf(g0 - gm) + __expf(g1 - gm) + __expf(g2 - gm) + __expf(g3 - gm));
            float e[8];
#pragma unroll
            for (int j = 0; j < 8; ++j) e[j] = lp[gi * 8 + j] * rs;
            int i1 = 0; float m1 = e[0];
#pragma unroll
            for (int j = 1; j < 8; ++j) if (e[j] > m1) { m1 = e[j]; i1 = j; }
            int i2 = (i1 == 0) ? 1 : 0; float m2 = -INFINITY;
#pragma unroll
            for (int j = 0; j < 8; ++j) if (j != i1 && e[j] > m2) { m2 = e[j]; i2 = j; }
            const float w2 = __expf(m2 - m1), gate1 = gtop / (1.f + w2), gate2 = gtop * w2 / (1.f + w2);
            const int lo = i1 < i2 ? i1 : i2, hix = i1 < i2 ? i2 : i1;
            const float glo = i1 < i2 ? gate1 : gate2, ghi = i1 < i2 ? gate2 : gate1;
            bucket = gi * 28 + (lo * (15 - lo)) / 2 + (hix - lo - 1);
            t_rs = rs; t_glo = glo; t_ghi = ghi; e_lo = gi * 8 + lo; e_hi = gi * 8 + hix;
            rank = __hip_atomic_fetch_add(&lcnt[bucket], 1, __ATOMIC_RELAXED, __HIP_MEMORY_SCOPE_WORKGROUP);
            r_lo = __hip_atomic_fetch_add(&ecl[e_lo], 1, __ATOMIC_RELAXED, __HIP_MEMORY_SCOPE_WORKGROUP); r_hi = __hip_atomic_fetch_add(&ecl[e_hi], 1, __ATOMIC_RELAXED, __HIP_MEMORY_SCOPE_WORKGROUP);
        }
        __syncthreads();
        if (F.tid < NBK) { const int c = lcnt[F.tid]; lbase[F.tid] = c ? (int)__hip_atomic_fetch_add(gcnt + F.tid, (unsigned)c, __ATOMIC_RELAXED, __HIP_MEMORY_SCOPE_AGENT) : 0; }
        if (F.tid >= 128 && F.tid < 160) { const int e = F.tid - 128, c = ecl[e]; ebl[e] = c ? (int)__hip_atomic_fetch_add(gecnt + e, (unsigned)c, __ATOMIC_RELAXED, __HIP_MEMORY_SCOPE_AGENT) : 0; }
        __syncthreads();
        if (hi == 0) { const int prow = lbase[bucket] + rank;
            list[(size_t)bucket * CAP + prow] = tok;
            tokinfo[tok] = (f32x4){t_rs, t_glo, t_ghi, 0.f}; ((unsigned*)(ws + WS_TOKROW))[tok] = ((unsigned)bucket << 16) | (unsigned)prow;
            elist[(size_t)e_lo * CAP + ebl[e_lo] + r_lo] = tok; elist[(size_t)e_hi * CAP + ebl[e_hi] + r_hi] = tok | (int)0x80000000; }
        __syncthreads();
    }
}

__device__ __forceinline__ int moe_prep(Frame F, int l, int coltiles) {
    asm volatile("" : "+s"(F.G), "+s"(F.vcu), "+s"(F.wave)); F.lane = lane_id(); asm volatile("" : "+v"(F.lane)); F.tid = F.wave * 64 + F.lane;
    LAS int* cntS = (LAS int*)(F.lds + CNT_OFF); LAS int* tst = (LAS int*)(F.lds + TST_OFF); LAS int* utab = (LAS int*)(F.lds + UNIT_OFF); LAS int* toktab = (LAS int*)(F.lds + TOK_OFF);
    unsigned char* ws = K_WS();
    const int* list = (const int*)(ws + WS_LIST);
    gu32* gcnt = (gu32*)(ws + WS_CTL) + CW_GCNT + l * 128;
    __syncthreads();
    if (F.tid < NBK) cntS[F.tid] = (int)__hip_atomic_load(gcnt + F.tid, __ATOMIC_RELAXED, __HIP_MEMORY_SCOPE_AGENT);
    __syncthreads();
    if (F.tid == 0) { int s = 0; for (int b = 0; b < NBK; ++b) { tst[b] = s; s += (cntS[b] + 255) >> 8; } tst[NBK] = s; }
    __syncthreads();
    const int ntile = tst[NBK], nunits = ntile * coltiles;
    int nmine = 0;
    for (int i = 0; i < MAXU; ++i) if (i * F.G + F.vcu < nunits) nmine = i + 1;
    if (F.tid < nmine) {
        const int L = F.tid * F.G + F.vcu, tg = L / coltiles, pn = L % coltiles;
        int bk = 0; for (int b = 0; b < NBK; ++b) if (tst[b] <= tg) bk = b;
        for (int b = 0; b < NBK; ++b) if (tst[b] <= tg && tg < tst[b + 1]) bk = b;
        int rows = cntS[bk] - (tg - tst[bk]) * 256; rows = rows > 256 ? 256 : rows;
        utab[F.tid * 4 + 0] = bk; utab[F.tid * 4 + 1] = tg; utab[F.tid * 4 + 2] = pn; utab[F.tid * 4 + 3] = rows;
    }
    __syncthreads();
    for (int idx = F.tid; idx < nmine * 256; idx += NTHREADS) {
        const int i = idx >> 8, r = idx & 255; const int bk = utab[i * 4 + 0], tg = utab[i * 4 + 1], rows = utab[i * 4 + 3];
        const int rr = r < rows ? r : 0;
        toktab[idx] = list[(size_t)bk * CAP + (tg - tst[bk]) * 256 + rr];
    }
    __syncthreads();
    return nmine;
}

__device__ __forceinline__ int moe_prep_e(Frame F, int l) {
    asm volatile("" : "+s"(F.G), "+s"(F.vcu), "+s"(F.wave)); F.lane = lane_id(); asm volatile("" : "+v"(F.lane)); F.tid = F.wave * 64 + F.lane;
    LAS int* cntS = (LAS int*)(F.lds + CNT_OFF); LAS int* tst = (LAS int*)(F.lds + TST_OFF); LAS int* utab = (LAS int*)(F.lds + UNIT_OFF); LAS int* toktab = (LAS int*)(F.lds + TOK_OFF);
    LAS int* etst = (LAS int*)(F.lds + LBASE_OFF); LAS int* ecnt = etst + 40;
    unsigned char* ws = K_WS();
    const int* elist = (const int*)(ws + WS_ELIST);
    gu32* gcnt = (gu32*)(ws + WS_CTL) + CW_GCNT + l * 128; gu32* gecnt = (gu32*)(ws + WS_CTL) + CW_ECNT + l * 32;
    __syncthreads();
    if (F.tid < NBK) cntS[F.tid] = (int)__hip_atomic_load(gcnt + F.tid, __ATOMIC_RELAXED, __HIP_MEMORY_SCOPE_AGENT);
    if (F.tid >= 128 && F.tid < 160) ecnt[F.tid - 128] = (int)__hip_atomic_load(gecnt + (F.tid - 128), __ATOMIC_RELAXED, __HIP_MEMORY_SCOPE_AGENT);
    __syncthreads();
    if (F.tid == 0) { int sp = 0; for (int b = 0; b < NBK; ++b) { tst[b] = sp; sp += (cntS[b] + 255) >> 8; } tst[NBK] = sp; }
    if (F.tid == 64) { int se = 0; for (int e = 0; e < NE; ++e) { etst[e] = se; se += (ecnt[e] + 255) >> 8; } etst[NE] = se; }
    __syncthreads();
    const int nunits = etst[NE] * 4;
    int nmine = 0;
    for (int i = 0; i < MAXU; ++i) if (i * F.G + F.vcu < nunits) nmine = i + 1;
    if (F.tid < nmine) {
        const int L = F.tid * F.G + F.vcu, tile = L >> 2, pn = L & 3;
        int e = 0; for (int b = 0; b < NE; ++b) if (etst[b] <= tile && tile < etst[b + 1]) e = b;
        int rows = ecnt[e] - (tile - etst[e]) * 256; rows = rows > 256 ? 256 : rows;
        utab[F.tid * 4 + 0] = e; utab[F.tid * 4 + 1] = tile - etst[e]; utab[F.tid * 4 + 2] = pn; utab[F.tid * 4 + 3] = rows;
    }
    __syncthreads();
    for (int idx = F.tid; idx < nmine * 256; idx += NTHREADS) {
        const int i = idx >> 8, r = idx & 255; const int e = utab[i * 4 + 0], tl = utab[i * 4 + 1], rows = utab[i * 4 + 3];
        toktab[idx] = elist[(size_t)e * CAP + tl * 256 + (r < rows ? r : 0)];
    }
    __syncthreads();
    return nmine;
}

__global__ void __launch_bounds__(NTHREADS, 2) mk_fwd(Args args) {
    Frame F;
    F.lds = LDSP(0);
    F.tid = 0; F.lane = 0; F.ws = nullptr; F.wave = __builtin_amdgcn_readfirstlane((int)threadIdx.x >> 6);
    F.G = gridDim.x; { const int bx = blockIdx.x; F.vcu = (F.G % 8 == 0) ? (bx % 8) * (F.G / 8) + bx / 8 : bx; }
    volatile LAS unsigned* MISC = (volatile LAS unsigned*)LDSP(MISC_OFF);
    if (threadIdx.x < 32) MISC[threadIdx.x] = 0u;
    __syncthreads();
    if (MK_N_LAUNCHES == 1) (void)xcd_barrier_post((unsigned*)(args.ws + WS_CTL) + CW_BAR, MISC + 8);
    const int lo = args.ph_lo, hi = args.ph_hi; (void)lo; (void)hi;
#if MK_N_LAUNCHES == 1
#define IN(k) true
#else
#define IN(k) (lo <= (k) && (k) < hi)
#endif
#define SEAM(k) do { if (IN(k) && IN((k) + 1) && (k) + 1 < NPHASE) { XcdBarrier bar_; bar_.bar = (unsigned*)(K_WS() + WS_CTL) + CW_BAR; bar_.st = (volatile LAS unsigned*)LDSP(MISC_OFF) + 8; xcd_barrier(bar_, F.wave); } } while (0)

    if (IN(0)) { p0_prologue(F); }
    SEAM(0);
    for (int l = 0; l < DEPTH; ++l) {
        const int pb = 1 + PPL * l;
        if (IN(pb)) {
            int G_ = F.G, bx_ = (int)blockIdx.x; asm volatile("" : "+s"(G_), "+s"(bx_));
            DenseSched S; S.a_off = WS_XN; S.b_off = WS_WIN + (size_t)l * PW * D * 2; S.pitchB = 2048; S.nN = PW / 256; S.c = bx_; S.G = G_;
            EpiQKV E{l};
            pg::gemm_phase<EpiQKV, DenseSched, false, false>(F.lds + RING_OFF, F.wave, S, E);
        }
        SEAM(pb);
        if (IN(pb + 1)) { p2_attn(F, l, 0); }
        SEAM(pb + 1);
        if (IN(pb + 2)) { p2_attn(F, l, 1); }
        SEAM(pb + 2);
        if (IN(pb + 3)) {
            int G_ = F.G, bx_ = (int)blockIdx.x; asm volatile("" : "+s"(G_), "+s"(bx_));
            DenseSched S; S.a_off = WS_MIXED; S.b_off = WS_WOUT + (size_t)l * D * D * 2; S.pitchB = 2048; S.nN = D / 256; S.c = bx_; S.G = G_;
            EpiRes E{l};
            pg::gemm_phase<EpiRes, DenseSched, false, false>(F.lds + RING_OFF, F.wave, S, E);
        }
        SEAM(pb + 3);
        if (IN(pb + 4)) { p5_router(F, l); }
        SEAM(pb + 4);
        if (IN(pb + 5)) {
            const int nmine = moe_prep_e(F, l);
            GuSched S; S.pitchB = 1024; S.l = l; S.nmine = nmine;
            EpiGU E{l};
            pg::gemm_phase<EpiGU, GuSched, true, true>(F.lds + RING_OFF, F.wave, S, E);
        }
        SEAM(pb + 5);
        if (IN(pb + 6)) {
            const int nmine = moe_prep(F, l, 4);
            DnSched S; S.pitchB = 512; S.l = l; S.nmine = nmine;
            EpiDown E{l};
            pg::gemm_phase<EpiDown, DnSched, true, true>(F.lds + RING_OFF, F.wave, S, E);
        }
        SEAM(pb + 6);
    }
#undef IN
#undef SEAM
}

extern "C" void kernel_launch(void* const* d_in, const int* in_sizes, int n_in, void* d_out, int out_size, void* d_ws, size_t ws_size, hipStream_t stream) {
    static int grid = 0;
    if (grid == 0) {
        if (n_in != 17 || out_size != T * D || ws_size < WS_END) { fprintf(stderr, "kernel_launch: unexpected shapes (n_in %d, out %d, ws %zu); nothing launched\n", n_in, out_size, ws_size); grid = -1; return; }
        int dev = 0, cus = 0;
        if (hipGetDevice(&dev) != hipSuccess || hipDeviceGetAttribute(&cus, hipDeviceAttributeMultiprocessorCount, dev) != hipSuccess) { grid = -1; return; }
        if (hipFuncSetAttribute((const void*)mk_fwd, hipFuncAttributeMaxDynamicSharedMemorySize, LDS_BYTES) != hipSuccess) { fprintf(stderr, "kernel_launch: hipFuncSetAttribute failed\n"); grid = -1; return; }
        int per_cu = 0;
        if (hipOccupancyMaxActiveBlocksPerMultiprocessor(&per_cu, (const void*)mk_fwd, NTHREADS, LDS_BYTES) != hipSuccess || per_cu < 1) fprintf(stderr, "kernel_launch: occupancy query says %d\n", per_cu);
        (void)hipGetLastError();
        grid = cus;
    }
    if (grid < 0) return;
    (void)in_sizes;
    if (hipMemsetAsync((char*)d_ws + WS_CTL, 0, CTL_ZERO_BYTES, stream) != hipSuccess) { fprintf(stderr, "kernel_launch: memset failed\n"); return; }
    Args a{};
    for (int i = 0; i < 17; ++i) a.in[i] = d_in[i];
    a.out = (float*)d_out; a.ws = (unsigned char*)d_ws;
    if (MK_N_LAUNCHES == 1) {
        a.ph_lo = 0; a.ph_hi = NPHASE;
        hipLaunchKernelGGL(mk_fwd, dim3(grid), dim3(NTHREADS), LDS_BYTES, stream, a);
    } else {
        for (int p = 0; p < NPHASE; ++p) { a.ph_lo = p; a.ph_hi = p + 1; hipLaunchKernelGGL(mk_fwd, dim3(grid), dim3(NTHREADS), LDS_BYTES, stream, a); }
    }
}
```
